# Optimizing an MI355X kernel written in HIP

```python
import jax, jax.numpy as jnp
from jax import lax
import numpy as np

D_MODEL = 2048
BATCH = 8
SEQ = 2048
DEPTH = 1

GRID_W = 64
CTX_LEN = 256
D_MIX = D_MODEL
RET_HEADS = 8
RET_HEAD_DIM = 128
D_RET = RET_HEADS * RET_HEAD_DIM
D_CONV = D_MIX - D_RET
D_IN = 4 * D_RET + 2 * D_CONV
CONV_WIDTH = 31
CONV_PAD = CONV_WIDTH // 2
CHUNK = 128
ROPE_BASE = 10000.0
N_EXPERTS = 32
TOP_K = 4
D_FF = D_MODEL
SWIGLU_ALPHA = 1.702
SWIGLU_LIMIT = 7.0
EPS = 1e-6
GN_EPS = 1e-5

kernel_name = 'hybrid_retention_conformer_moe_dit_layer'


def rms_norm(x, w):
    xf = x.astype(jnp.float32)
    y = xf * lax.rsqrt(jnp.mean(xf * xf, axis=-1, keepdims=True) + EPS)
    return (y * w.astype(jnp.float32)).astype(x.dtype)


def modulate(h, shift, scale):
    return h * (1 + scale) + shift


def to_heads(t):
    b, n, _ = t.shape
    return t.reshape(b, n, RET_HEADS, RET_HEAD_DIM).transpose(0, 2, 1, 3).astype(jnp.float32)


def rotary(t, pos):
    half = RET_HEAD_DIM // 2
    inv = ROPE_BASE ** (-jnp.arange(half, dtype=jnp.float32) / half)
    ang = pos[:, None] * inv[None, :]
    cos, sin = jnp.cos(ang), jnp.sin(ang)
    t1, t2 = t[..., :half], t[..., half:]
    return jnp.concatenate([t1 * cos - t2 * sin, t1 * sin + t2 * cos], axis=-1)


def retention_chunked(q, k, v, log_g, state0):
    b, h, n, d = q.shape
    nc = n // CHUNK

    def chunks(t):
        return t.reshape(b, h, nc, CHUNK, d).transpose(2, 0, 1, 3, 4)

    idx = jnp.arange(CHUNK, dtype=jnp.float32)
    diff = idx[:, None] - idx[None, :]
    decay_in = jnp.where(diff >= 0, jnp.exp(log_g[:, None, None] * jnp.maximum(diff, 0.0)), 0.0)
    decay_q = jnp.exp(log_g[:, None] * (idx + 1.0))[:, :, None]
    decay_k = jnp.exp(log_g[:, None] * (CHUNK - 1.0 - idx))[:, :, None]
    decay_c = jnp.exp(log_g * CHUNK)[:, None, None]

    def step(state, qkv):
        qi, ki, vi = qkv
        scores = jnp.einsum('bhid,bhjd->bhij', qi, ki) * decay_in
        out = (jnp.einsum('bhij,bhje->bhie', scores, vi)
               + jnp.einsum('bhid,bhde->bhie', qi, state) * decay_q)
        state = state * decay_c + jnp.einsum('bhjd,bhje->bhde', ki * decay_k, vi)
        return state, out

    _, out = lax.scan(step, state0, (chunks(q), chunks(k), chunks(v)))
    return out.transpose(1, 2, 0, 3, 4).reshape(b, h, n, d)


def retention_state(k, v, log_g):
    n = k.shape[2]
    w = jnp.exp(log_g[:, None] * (n - 1.0 - jnp.arange(n, dtype=jnp.float32)))
    return jnp.einsum('bhtd,bhte,ht->bhde', k, v, w)


def bidirectional_retention(q, k, v, lg_f, lg_b, state_f, state_b):
    fwd = retention_chunked(q, k, v, lg_f, state_f)
    bwd = retention_chunked(q[:, :, ::-1], k[:, :, ::-1], v[:, :, ::-1], lg_b, state_b)
    return fwd + bwd[:, :, ::-1]


def retention_group_out(o, g, gn_w):
    mu = jnp.mean(o, axis=-1, keepdims=True)
    var = jnp.mean(jnp.square(o - mu), axis=-1, keepdims=True)
    on = (o - mu) * lax.rsqrt(var + GN_EPS)
    b, h, n, d = o.shape
    on = on.transpose(0, 2, 1, 3).reshape(b, n, h * d) * gn_w.astype(jnp.float32)
    return on * jax.nn.silu(g.astype(jnp.float32))


def conformer_conv(a, gate, conv_w, conv_b, ln_w, ln_b, n_seq, seq_len):
    u = a * jax.nn.sigmoid(gate)
    b, n, ch = u.shape
    u = u.reshape(n_seq, seq_len, ch)
    u = lax.conv_general_dilated(u, conv_w[:, None, :].astype(u.dtype), window_strides=(1,),
                                 padding=[(CONV_PAD, CONV_PAD)],
                                 dimension_numbers=('NWC', 'WIO', 'NWC'),
                                 feature_group_count=ch)
    u = (u + conv_b).reshape(b, n, ch).astype(jnp.float32)
    mu = jnp.mean(u, axis=-1, keepdims=True)
    var = jnp.mean(jnp.square(u - mu), axis=-1, keepdims=True)
    u = (u - mu) * lax.rsqrt(var + EPS) * ln_w.astype(jnp.float32) + ln_b.astype(jnp.float32)
    return jax.nn.silu(u)


def parallel_mixer(h_lat, h_ctx, w_in, dec_f, dec_b, gn_w, conv_w, conv_b, ln_w, ln_b, w_out,
                   need_ctx_out):
    b, s, _ = h_lat.shape
    n_ctx = h_ctx.shape[1]
    rows = s // GRID_W
    pos_ctx = jnp.arange(n_ctx, dtype=jnp.float32)
    pos_lat = n_ctx + jnp.arange(s, dtype=jnp.float32)
    lg_f = jax.nn.log_sigmoid(dec_f.astype(jnp.float32))
    lg_b = jax.nn.log_sigmoid(dec_b.astype(jnp.float32))
    splits = [D_RET, 2 * D_RET, 3 * D_RET, 4 * D_RET, 4 * D_RET + D_CONV]
    q, k, v, g, ca, cb = jnp.split(h_lat @ w_in, splits, axis=-1)
    if need_ctx_out:
        qc, kc, vc, gc, cac, cbc = jnp.split(h_ctx @ w_in, splits, axis=-1)
    else:
        kc, vc = jnp.split(h_ctx @ w_in[:, D_RET:3 * D_RET], 2, axis=-1)
    q_scale = RET_HEAD_DIM ** -0.5
    kc = rotary(to_heads(kc), pos_ctx)
    vc = to_heads(vc)
    state_f = retention_state(kc, vc, lg_f)
    state_b = retention_state(kc[:, :, ::-1], vc[:, :, ::-1], lg_b)
    o_lat = bidirectional_retention(rotary(to_heads(q), pos_lat) * q_scale, rotary(to_heads(k), pos_lat),
                                    to_heads(v), lg_f, lg_b, state_f, state_b)
    y_lat = jnp.concatenate([retention_group_out(o_lat, g, gn_w),
                             conformer_conv(ca, cb, conv_w, conv_b, ln_w, ln_b, b * rows, GRID_W)], axis=-1)
    mix_lat = y_lat.astype(h_lat.dtype) @ w_out
    if not need_ctx_out:
        return mix_lat, None
    zero = jnp.zeros((b, RET_HEADS, RET_HEAD_DIM, RET_HEAD_DIM), jnp.float32)
    o_ctx = bidirectional_retention(rotary(to_heads(qc), pos_ctx) * q_scale, kc, vc, lg_f, lg_b, zero, zero)
    y_ctx = jnp.concatenate([retention_group_out(o_ctx, gc, gn_w),
                             conformer_conv(cac, cbc, conv_w, conv_b, ln_w, ln_b, b, n_ctx)], axis=-1)
    return mix_lat, y_ctx.astype(h_ctx.dtype) @ w_out


def moe_ffn(h, router_w, router_b, w1, b1, w2, b2):
    shp = h.shape
    hf = h.reshape(-1, shp[-1])
    logits = (hf @ router_w + router_b).astype(jnp.float32)
    top_val, top_idx = lax.top_k(logits, TOP_K)
    top_w = jax.nn.softmax(top_val, axis=-1)
    gates = jnp.einsum('nk,nke->ne', top_w, jax.nn.one_hot(top_idx, N_EXPERTS, dtype=jnp.float32))
    out = jnp.zeros(hf.shape, jnp.float32)
    for e in range(N_EXPERTS):
        u = hf @ w1[e] + b1[e]
        glu = jnp.minimum(u[:, :D_FF], SWIGLU_LIMIT)
        lin = jnp.clip(u[:, D_FF:], -SWIGLU_LIMIT, SWIGLU_LIMIT)
        act = glu * jax.nn.sigmoid(SWIGLU_ALPHA * glu) * (lin + 1)
        out = out + gates[:, e:e + 1] * (act @ w2[e] + b2[e]).astype(jnp.float32)
    return out.reshape(shp).astype(h.dtype)


def setup_inputs(seed: int = 0) -> dict:
    key = jax.random.key(seed)
    ks = jax.random.split(key, 26)

    def nrm(k, shape, scale):
        return scale * jax.random.normal(k, shape, jnp.float32)

    base = 1.0 - 2.0 ** (-5.0 - np.arange(RET_HEADS, dtype=np.float32))
    decay_logit = jnp.asarray(np.log(base / (1.0 - base)), jnp.float32)
    return {
        'x': nrm(ks[0], (BATCH, SEQ, D_MODEL), 1.0),
        'c': nrm(ks[1], (BATCH, D_MODEL), 1.0),
        'ctx': nrm(ks[2], (BATCH, CTX_LEN, D_MODEL), 1.0),
        'c_ctx': nrm(ks[3], (D_MODEL,), 1.0),
        'ada_w': nrm(ks[4], (DEPTH, D_MODEL, 6 * D_MODEL), 0.5 * D_MODEL ** -0.5),
        'ada_b': nrm(ks[5], (DEPTH, 6 * D_MODEL), 0.02),
        'pre_mix_norm': 1.0 + nrm(ks[6], (DEPTH, D_MODEL), 0.05),
        'post_mix_norm': 1.0 + nrm(ks[7], (DEPTH, D_MODEL), 0.05),
        'pre_ffn_norm': 1.0 + nrm(ks[8], (DEPTH, D_MODEL), 0.05),
        'post_ffn_norm': 1.0 + nrm(ks[9], (DEPTH, D_MODEL), 0.05),
        'w_in': nrm(ks[10], (DEPTH, D_MODEL, D_IN), D_MODEL ** -0.5),
        'ret_decay_fwd': decay_logit[None, :] + nrm(ks[11], (DEPTH, RET_HEADS), 0.1),
        'ret_decay_bwd': decay_logit[None, :] + nrm(ks[12], (DEPTH, RET_HEADS), 0.1),
        'ret_gn_w': 1.0 + nrm(ks[13], (DEPTH, D_RET), 0.05),
        'conv_w': nrm(ks[14], (DEPTH, CONV_WIDTH, D_CONV), CONV_WIDTH ** -0.5),
        'conv_b': nrm(ks[15], (DEPTH, D_CONV), 0.02),
        'conv_ln_w': 1.0 + nrm(ks[16], (DEPTH, D_CONV), 0.05),
        'conv_ln_b': nrm(ks[17], (DEPTH, D_CONV), 0.02),
        'w_out': nrm(ks[18], (DEPTH, D_MIX, D_MODEL), D_MIX ** -0.5),
        'router_w': nrm(ks[19], (DEPTH, D_MODEL, N_EXPERTS), D_MODEL ** -0.5),
        'router_b': nrm(ks[20], (DEPTH, N_EXPERTS), 0.01),
        'w1': nrm(ks[21], (DEPTH, N_EXPERTS, D_MODEL, 2 * D_FF), D_MODEL ** -0.5),
        'b1': nrm(ks[22], (DEPTH, N_EXPERTS, 2 * D_FF), 0.02),
        'w2': nrm(ks[23], (DEPTH, N_EXPERTS, D_FF, D_MODEL), D_FF ** -0.5),
        'b2': nrm(ks[24], (DEPTH, N_EXPERTS, D_MODEL), 0.02),
    }


def reference(x, c, ctx, c_ctx, ada_w, ada_b, pre_mix_norm, post_mix_norm, pre_ffn_norm, post_ffn_norm,
              w_in, ret_decay_fwd, ret_decay_bwd, ret_gn_w, conv_w, conv_b, conv_ln_w, conv_ln_b, w_out,
              router_w, router_b, w1, b1, w2, b2):
    ctx_h = ctx
    for l in range(DEPTH):
        last = l == DEPTH - 1
        mod_lat = jax.nn.silu(c) @ ada_w[l] + ada_b[l]
        sh1, sc1, g1, sh2, sc2, g2 = [m[:, None, :] for m in jnp.split(mod_lat, 6, axis=-1)]
        mod_ctx = jax.nn.silu(c_ctx) @ ada_w[l] + ada_b[l]
        csh1, csc1, cg1, csh2, csc2, cg2 = jnp.split(mod_ctx, 6, axis=-1)

        h_lat = modulate(rms_norm(x, pre_mix_norm[l]), sh1, sc1)
        h_ctx = modulate(rms_norm(ctx_h, pre_mix_norm[l]), csh1, csc1)
        mix_lat, mix_ctx = parallel_mixer(h_lat, h_ctx, w_in[l], ret_decay_fwd[l], ret_decay_bwd[l],
                                          ret_gn_w[l], conv_w[l], conv_b[l], conv_ln_w[l], conv_ln_b[l],
                                          w_out[l], not last)
        x = x + g1 * rms_norm(mix_lat, post_mix_norm[l])

        h = modulate(rms_norm(x, pre_ffn_norm[l]), sh2, sc2)
        x = x + g2 * rms_norm(moe_ffn(h, router_w[l], router_b[l], w1[l], b1[l], w2[l], b2[l]),
                              post_ffn_norm[l])

        if not last:
            ctx_h = ctx_h + cg1 * rms_norm(mix_ctx, post_mix_norm[l])
            hc = modulate(rms_norm(ctx_h, pre_ffn_norm[l]), csh2, csc2)
            ctx_h = ctx_h + cg2 * rms_norm(moe_ffn(hc, router_w[l], router_b[l], w1[l], b1[l], w2[l], b2[l]),
                                            post_ffn_norm[l])
    return x
```

```cpp
#include <hip/hip_runtime.h>
#include <cstdio>
#include <cstdint>

#ifndef N_LAUNCH_MODE
#define N_LAUNCH_MODE 1
#endif

#define LAS __attribute__((address_space(3)))
typedef unsigned short bf16_t;
typedef short bf16x8 __attribute__((ext_vector_type(8)));
typedef short s16x4 __attribute__((ext_vector_type(4)));
typedef float f32x4 __attribute__((ext_vector_type(4)));
typedef float f32x2 __attribute__((ext_vector_type(2)));
typedef unsigned u32x4 __attribute__((ext_vector_type(4)));
typedef unsigned u32x2 __attribute__((ext_vector_type(2)));
typedef int i32x4 __attribute__((ext_vector_type(4)));
typedef int i32x8 __attribute__((ext_vector_type(8)));
typedef int i32x16 __attribute__((ext_vector_type(16)));
typedef int i32x32 __attribute__((ext_vector_type(32)));

constexpr int NB = 8, SEQ = 2048, DM = 2048, NTOK = NB * SEQ, CTXL = 256, NCTX = NB * CTXL;
constexpr int NH = 8, HD = 128, DRET = 1024, DCONV = 1024, DIN = 6144, CONVW = 31, CONVP = 15, CHUNK = 128, NCHUNK = SEQ / CHUNK;
constexpr int NE = 32, TOPK = 4, DFF = 2048, GRIDW = 64;
constexpr float EPS = 1e-6f, GN_EPS = 1e-5f;
constexpr int MAXTILES = NTOK * TOPK / 256 + NE;
constexpr int NPHASE = 10;

constexpr size_t MiB = 1u << 20;
constexpr size_t WS_CTL = 0, CTL_ZERO_BYTES = 65536;
constexpr size_t WS_MOD = 1 * MiB;
constexpr size_t WS_RWT = 2 * MiB;
constexpr size_t WS_WIN = 4 * MiB;
constexpr size_t WS_WOUT = 28 * MiB;
constexpr size_t WS_W1 = 36 * MiB;
constexpr size_t WS_W2 = 548 * MiB;
constexpr size_t WS_HLAT = 804 * MiB;
constexpr size_t WS_HCTX = 868 * MiB;
constexpr size_t WS_Q = 876 * MiB, WS_K = 908 * MiB, WS_V = 940 * MiB, WS_G = 972 * MiB, WS_U = 1004 * MiB;
constexpr size_t WS_KC = 1036 * MiB, WS_VC = 1040 * MiB;
constexpr size_t WS_SF = 1044 * MiB, WS_SB = 1076 * MiB;
constexpr size_t WS_Y = 1108 * MiB;
constexpr size_t WS_MIX = 1172 * MiB;
constexpr size_t WS_X1 = 1300 * MiB;
constexpr size_t WS_H2 = 1428 * MiB;
constexpr size_t WS_TOKE = 1492 * MiB, WS_TOKG = 1493 * MiB, WS_TOKS = 1494 * MiB;
constexpr size_t WS_LIST = 1495 * MiB;
constexpr size_t WS_ACT = 1497 * MiB;
constexpr size_t WS_Y2 = 1785 * MiB;
constexpr size_t WS_H8 = 2073 * MiB;
constexpr size_t WS_WIN8 = 2105 * MiB;
constexpr size_t WS_END = 2109 * MiB;
constexpr int CW_TMO = 0, CW_BAR = 4096, CW_CNT = 8192;

constexpr int RING_BYTES = 139264;
constexpr int MISC_OFF = RING_BYTES;
constexpr int PTAB_OFF = MISC_OFF + 640;
constexpr int GTAB_OFF = MISC_OFF + 1024;
constexpr int MAXU = 20;
constexpr int LDS_BYTES = GTAB_OFF + MAXU * 1024;
static_assert(LDS_BYTES <= 163840, "LDS");

__device__ __forceinline__ unsigned cvt_pk_bf16(float lo, float hi) { unsigned r; asm("v_cvt_pk_bf16_f32 %0, %1, %2" : "=v"(r) : "v"(lo), "v"(hi)); return r; }
__device__ __forceinline__ float bf_lo(unsigned u) { return __uint_as_float(u << 16); }
__device__ __forceinline__ float bf_hi(unsigned u) { return __uint_as_float(u & 0xffff0000u); }
__device__ __forceinline__ float bf1(bf16_t b) { return __uint_as_float(((unsigned)b) << 16); }
__device__ __forceinline__ float wave_sum(float v) {
#pragma unroll
    for (int o = 32; o >= 1; o >>= 1) v += __shfl_xor(v, o);
    return v; }
__device__ __forceinline__ float sigmoidf_(float x) { return __builtin_amdgcn_rcpf(1.0f + __expf(-x)); }
__device__ __forceinline__ float siluf_(float x) { return x * sigmoidf_(x); }
__device__ __forceinline__ float log_sigmoid_(float x) { return fminf(x, 0.f) - log1pf(__expf(-fabsf(x))); }
constexpr float FP8_AS = 4.0f, FP8_BS = 64.0f, FP8_DESCALE = 1.0f / (FP8_AS * FP8_BS);
__device__ __forceinline__ unsigned cvt4_fp8(float a, float b, float c, float d) { int p = __builtin_amdgcn_cvt_pk_fp8_f32(a, b, 0, false); p = __builtin_amdgcn_cvt_pk_fp8_f32(c, d, p, true); return (unsigned)p; }
__device__ __forceinline__ int get_lane() { int l; asm volatile("v_mbcnt_lo_u32_b32 %0, -1, 0\n\tv_mbcnt_hi_u32_b32 %0, -1, %0" : "=v"(l)); return l; }
__host__ __device__ __forceinline__ int slot128(int r) { return 32 * (r >> 5) + 16 * ((r >> 2) & 1) + 4 * ((r >> 3) & 3) + (r & 3); }

#define XB_TMO      128
#define XB_XCNT(j)  (256  + 64 * (j))
#define XB_XSUB(j)  (1280 + 64 * (j))
#define XB_XGEN(j)  (2304 + 64 * (j))
#define XB_TOP      3328
#define XB_TOPGEN   3392
#define XCD_BAR_WORDS 3456
#define XB_SPIN_CAP (1u << 18)

__device__ __forceinline__ unsigned xb_ld(unsigned* p)              { return __hip_atomic_load(p, __ATOMIC_RELAXED, __HIP_MEMORY_SCOPE_AGENT); }
__device__ __forceinline__ unsigned xb_add(unsigned* p, unsigned v) { return __hip_atomic_fetch_add(p, v, __ATOMIC_RELAXED, __HIP_MEMORY_SCOPE_AGENT); }
__device__ __forceinline__ unsigned xb_xcc_id() { return (unsigned)__builtin_amdgcn_s_getreg((3 << 11) | 20) & 0xFu; }
#define XB_SPIN(cond, bar) do { unsigned _sp = 0; while (cond) { __builtin_amdgcn_s_sleep(1); \
    if ((++_sp & 255u) == 0u) { if (xb_ld(&(bar)[XB_TMO])) break; if (_sp > XB_SPIN_CAP) { atomicAdd(&(bar)[XB_TMO], 1u); break; } } } } while (0)

struct XcdBarrier { unsigned* bar; unsigned x; volatile LAS unsigned* st; int w0; };

__device__ __forceinline__ XcdBarrier xcd_barrier_post(unsigned* bar, volatile LAS unsigned* st) {
    XcdBarrier b; b.bar = bar; b.x = xb_xcc_id(); b.st = st; b.w0 = 0;
    if (threadIdx.x == 0) (void)xb_add(&bar[XB_XCNT(b.x)], 1u);
    return b;
}
__device__ __forceinline__ void xcd_barrier_complete(unsigned* bar, unsigned x, unsigned& nloc, unsigned& nx) {
    const unsigned G = gridDim.x * gridDim.y * gridDim.z;
    unsigned sum, cnt, mine, sp = 0u;
    for (;;) {
        sum = 0u; cnt = 0u; mine = 0u;
#pragma unroll
        for (unsigned j = 0; j < 16; ++j) { const unsigned c = xb_ld(&bar[XB_XCNT(j)]); sum += c; cnt += (c > 0u) ? 1u : 0u; mine = (j == x) ? c : mine; }
        if (sum == G) break;
        __builtin_amdgcn_s_sleep(1);
        if ((++sp & 255u) == 0u) { if (xb_ld(&bar[XB_TMO])) break; if (sp > XB_SPIN_CAP) { atomicAdd(&bar[XB_TMO], 1u); break; } }
    }
    nloc = mine > 0u ? mine : 1u; nx = cnt > 0u ? cnt : 1u;
}
__device__ __forceinline__ void xcd_barrier(const XcdBarrier& b) {
    asm volatile("s_waitcnt vmcnt(0)" ::: "memory");
    __syncthreads();
    if (b.w0 && get_lane() == 0) {
        unsigned* bar = b.bar;
        __builtin_amdgcn_s_waitcnt(0);
        unsigned nloc = b.st[0], nx = b.st[1];
        if (nloc == 0u) { xcd_barrier_complete(bar, b.x, nloc, nx); b.st[0] = nloc; b.st[1] = nx; }
        const unsigned old = xb_add(&bar[XB_XSUB(b.x)], 1u);
        const unsigned gen = old / nloc;
        if (old + 1u == (gen + 1u) * nloc) {
            __builtin_amdgcn_fence(__ATOMIC_RELEASE, "agent");
            asm volatile("s_waitcnt vmcnt(0)" ::: "memory");
            const unsigned og = xb_add(&bar[XB_TOP], 1u);
            const unsigned tg = og / nx;
            if (og + 1u == (tg + 1u) * nx) xb_add(&bar[XB_TOPGEN], 1u);
            else XB_SPIN(xb_ld(&bar[XB_TOPGEN]) == tg, bar);
            __builtin_amdgcn_fence(__ATOMIC_ACQUIRE, "agent");
            xb_add(&bar[XB_XGEN(b.x)], 1u);
            asm volatile("s_waitcnt vmcnt(0)" ::: "memory");
        } else {
            XB_SPIN(xb_ld(&bar[XB_XGEN(b.x)]) == gen, bar);
            __builtin_amdgcn_fence(__ATOMIC_ACQUIRE, "agent");
            asm volatile("s_waitcnt vmcnt(0)" ::: "memory");
        }
    }
    __syncthreads();
}

namespace pg8 {
constexpr int BM = 256, BK = 64, HALF = 128, HTB = HALF * BK * 2, STAGE_BYTES = 8 * HTB, NXCD = 8, WGM = 8;
__host__ __device__ __forceinline__ int lds_byte(int r, int c) { const int st = (r >> 4) * 2 + (c >> 5), rr = r & 15, cc = c & 31, ob = rr * 64 + cc * 2; return st * 1024 + (ob ^ (((ob >> 9) & 1) << 5)); }
__host__ __device__ __forceinline__ void stage_rc(int b, int& R, int& C) { const int st = b / 1024, sb = b % 1024, swz = sb ^ (((sb >> 9) & 1) << 5); R = (st >> 1) * 16 + swz / 64; C = (st & 1) * 32 + (swz % 64) / 2; }

struct Unit { int pm, pn, aux; };
__device__ __forceinline__ unsigned vadd_opaque(unsigned a, unsigned k) { unsigned r; asm volatile("v_add_u32 %0, %1, %2" : "=v"(r) : "v"(a), "s"(k)); return r; }
__device__ __forceinline__ i32x8 cat8(bf16x8 lo, bf16x8 hi) { const i32x4 a = (i32x4)lo, b = (i32x4)hi; return __builtin_shufflevector(a, b, 0, 1, 2, 3, 4, 5, 6, 7); }
__device__ __forceinline__ bf16x8 lo8(i32x8 v) { return (bf16x8)__builtin_shufflevector(v, v, 0, 1, 2, 3); }
__device__ __forceinline__ bf16x8 hi8(i32x8 v) { return (bf16x8)__builtin_shufflevector(v, v, 4, 5, 6, 7); }
__device__ __forceinline__ bool static_order(int nM, int nN, int G, int c, int i, int& pm, int& pn) {
    const int nwg = nM * nN; const long L = (long)i * G + c; if (L >= nwg) return false;
    int wgid = (int)L; { const int q = nwg / NXCD, r = nwg % NXCD, xcd = wgid % NXCD, off = wgid / NXCD; wgid = (xcd < r ? xcd * (q + 1) : r * (q + 1) + (xcd - r) * q) + off; }
    const int nig = WGM * nN, gid = wgid / nig, fm = gid * WGM, gsz = (nM - fm) < WGM ? (nM - fm) : WGM;
    pm = fm + ((wgid % nig) % gsz); pn = (wgid % nig) / gsz; return true;
}

template <class Epi, class Sched, bool GATHER, bool FP8, bool SPLIT = FP8>
__device__ __forceinline__ void gemm_phase(LAS unsigned char* lds, unsigned char* wsbase, const int wid, const int RB, const Sched& S, const Epi& E, const LAS unsigned* gtab) {
    const int lane = get_lane(), tid = wid * 64 + lane, wr = wid >> 2, wc = wid & 3, fr = lane & 15, fq = lane >> 4;
    const int nt = RB / 128;
    const __amdgpu_buffer_rsrc_t rs = __builtin_amdgcn_make_buffer_rsrc((void*)wsbase, 0, -1, 0x00020000);
    unsigned voff0; int rowA0;
    { int R, C; stage_rc(tid * 16, R, C); voff0 = (unsigned)(R * RB + C * 2); rowA0 = R; }
#define PG8_VOFF(i_) ((i_) == 0 ? voff0 : vadd_opaque(voff0, 64u * (unsigned)RB))
#define PG8_ROWA(i_) ((i_) == 0 ? rowA0 : (int)vadd_opaque((unsigned)rowA0, 64u))
    const unsigned kstep = 128u;
    const unsigned hstep = (unsigned)HALF * (unsigned)RB;
    const unsigned ahstep = GATHER ? 0u : hstep;
    const unsigned ldsw = (unsigned)wid * 1024u;
    const int aoff = lds_byte(wr * 64 + fr, fq * 8), boff = lds_byte(wc * 32 + fr, fq * 8);
#define PG8_SA(b, h) (((b) * 2 + (h)) * HTB)
#define PG8_SB(b, h) ((4 + (b) * 2 + (h)) * HTB)
#define PG8_STAGE_B(bufoff, soff) do { _Pragma("unroll") for (int _i = 0; _i < 2; ++_i) \
        __builtin_amdgcn_raw_ptr_buffer_load_lds(rs, (LAS void*)(lds + (bufoff) + ldsw + _i * 8192), 16, PG8_VOFF(_i), (soff), 0, 0); } while (0)
#define PG8_GOFF(h, uidx) do { if constexpr (GATHER) { _Pragma("unroll") for (int _i = 0; _i < 2; ++_i) go[_i] = gtab[(uidx) * 256 + (h) * 128 + PG8_ROWA(_i)] + (voff0 - (unsigned)(rowA0 * RB)); } } while (0)
#define PG8_STAGE_A(bufoff, soff, h) do { _Pragma("unroll") for (int _i = 0; _i < 2; ++_i) \
        __builtin_amdgcn_raw_ptr_buffer_load_lds(rs, (LAS void*)(lds + (bufoff) + ldsw + _i * 8192), 16, GATHER ? go[_i] : PG8_VOFF(_i), (soff) + (unsigned)(h) * ahstep, 0, 0); } while (0)
#define PG8_LD8(addr) cat8(*(const LAS bf16x8*)(addr), *(const LAS bf16x8*)((addr) + 1024))
#define PG8_LDA(dst, b, h) do { _Pragma("unroll") for (int m = 0; m < 4; ++m) dst[m] = PG8_LD8(lds + PG8_SA(b, h) + aoff + m * 2048); } while (0)
#define PG8_LDA2(dst, b, h, m0) do { _Pragma("unroll") for (int m = 0; m < 2; ++m) dst[m] = PG8_LD8(lds + PG8_SA(b, h) + aoff + ((m0) + m) * 2048); } while (0)
#define PG8_LDB(dst, b, h) do { _Pragma("unroll") for (int n = 0; n < 2; ++n) dst[n] = PG8_LD8(lds + PG8_SB(b, h) + boff + n * 2048); } while (0)
#define PG8_MMA(ai, bj, At, Bt) do { __builtin_amdgcn_s_setprio(1); _Pragma("unroll") for (int m = 0; m < 4; ++m) _Pragma("unroll") for (int n = 0; n < 2; ++n) { \
        if constexpr (FP8) { acc[ai][bj][m][n] = __builtin_amdgcn_mfma_scale_f32_16x16x128_f8f6f4(Bt[n], At[m], acc[ai][bj][m][n], 0, 0, 0, 0x7F7F7F7F, 0, 0x7F7F7F7F); } \
        else { acc[ai][bj][m][n] = __builtin_amdgcn_mfma_f32_16x16x32_bf16(lo8(Bt[n]), lo8(At[m]), acc[ai][bj][m][n], 0, 0, 0); \
               acc[ai][bj][m][n] = __builtin_amdgcn_mfma_f32_16x16x32_bf16(hi8(Bt[n]), hi8(At[m]), acc[ai][bj][m][n], 0, 0, 0); } } \
        __builtin_amdgcn_s_setprio(0); } while (0)
#define PG8_MMA2(ai, At, m0) do { __builtin_amdgcn_s_setprio(1); _Pragma("unroll") for (int m = 0; m < 2; ++m) _Pragma("unroll") for (int n = 0; n < 2; ++n) { \
        acc[ai][0][(m0) + m][n] = __builtin_amdgcn_mfma_scale_f32_16x16x128_f8f6f4(B0[n], At[m], acc[ai][0][(m0) + m][n], 0, 0, 0, 0x7F7F7F7F, 0, 0x7F7F7F7F); \
        acc[ai][1][(m0) + m][n] = __builtin_amdgcn_mfma_scale_f32_16x16x128_f8f6f4(B1[n], At[m], acc[ai][1][(m0) + m][n], 0, 0, 0, 0x7F7F7F7F, 0, 0x7F7F7F7F); } \
        __builtin_amdgcn_s_setprio(0); } while (0)
#define PG8_WAIT_V(n) asm volatile("s_waitcnt vmcnt(" #n ")" ::: "memory")
#define PG8_WAIT_L(n) asm volatile("s_waitcnt lgkmcnt(" #n ")" ::: "memory")
#define PG8_BAR __builtin_amdgcn_s_barrier()
#define PG8_SCHED __builtin_amdgcn_sched_barrier(0)
    Unit cur, nxt; int ui = 0;
    if (!S.next(0, cur)) return;
    f32x4 acc[2][2][4][2];
#pragma unroll
    for (int a = 0; a < 2; ++a)
#pragma unroll
        for (int b = 0; b < 2; ++b)
#pragma unroll
            for (int m = 0; m < 4; ++m)
#pragma unroll
                for (int n = 0; n < 2; ++n) acc[a][b][m][n] = (f32x4){0.f, 0.f, 0.f, 0.f};
    i32x8 At[SPLIT ? 2 : 4], B0[2], B1[2];
    unsigned cA = S.abase(cur), cB = S.bbase(cur);
    unsigned go[2] = {0u, 0u};
    PG8_STAGE_B(PG8_SB(0, 0), cB); PG8_STAGE_B(PG8_SB(0, 1), cB + hstep); PG8_GOFF(0, 0); PG8_STAGE_A(PG8_SA(0, 0), cA, 0); PG8_GOFF(1, 0); PG8_STAGE_A(PG8_SA(0, 1), cA, 1);
    if (wr == 1) PG8_BAR;
    PG8_WAIT_V(2); PG8_BAR;
    PG8_STAGE_B(PG8_SB(1, 0), cB + kstep); PG8_GOFF(0, 0); PG8_STAGE_A(PG8_SA(1, 0), cA + kstep, 0); PG8_STAGE_B(PG8_SB(1, 1), cB + hstep + kstep);
    PG8_WAIT_V(6); PG8_BAR;
    for (;;) {
        const bool has_next = S.next(ui + 1, nxt);
        const unsigned nA = has_next ? S.abase(nxt) : cA, nB = has_next ? S.bbase(nxt) : cB;
        for (int t = 0; t < nt; t += 2) {
            const bool last = (t == nt - 2);
            const bool nx = last && has_next;
            const unsigned a1 = cA + (unsigned)(t + 1) * kstep;
            const unsigned a2 = last ? nA : cA + (unsigned)(t + 2) * kstep, b2 = last ? nB : cB + (unsigned)(t + 2) * kstep;
            const unsigned a3 = a2 + kstep, b3 = b2 + kstep;
            const int un = nx ? ui + 1 : ui;
            if constexpr (!SPLIT) {
            PG8_GOFF(1, ui); PG8_LDB(B0, 0, 0); PG8_LDB(B1, 0, 1); PG8_SCHED; PG8_LDA(At, 0, 0); PG8_STAGE_A(PG8_SA(1, 1), a1, 1);
            PG8_WAIT_V(8); PG8_WAIT_L(0); PG8_BAR; PG8_MMA(0, 0, At, B0); PG8_MMA(0, 1, At, B1); PG8_BAR; PG8_SCHED;
            PG8_GOFF(0, un); PG8_LDA(At, 0, 1); PG8_STAGE_B(PG8_SB(0, 0), b2); PG8_STAGE_B(PG8_SB(0, 1), b2 + hstep); PG8_STAGE_A(PG8_SA(0, 0), a2, 0);
            PG8_WAIT_V(8); PG8_WAIT_L(0); PG8_BAR; PG8_MMA(1, 0, At, B0); PG8_MMA(1, 1, At, B1); PG8_BAR; PG8_SCHED;
            PG8_GOFF(1, un); PG8_LDB(B0, 1, 0); PG8_LDB(B1, 1, 1); PG8_SCHED; PG8_LDA(At, 1, 0); PG8_STAGE_A(PG8_SA(0, 1), a2, 1);
            PG8_WAIT_V(8); PG8_WAIT_L(0); PG8_BAR; PG8_MMA(0, 0, At, B0); PG8_MMA(0, 1, At, B1); PG8_BAR; PG8_SCHED;
            PG8_GOFF(0, un); PG8_LDA(At, 1, 1); PG8_STAGE_B(PG8_SB(1, 0), b3); PG8_STAGE_B(PG8_SB(1, 1), b3 + hstep); PG8_STAGE_A(PG8_SA(1, 0), a3, 0);
            PG8_WAIT_V(8); PG8_WAIT_L(0); PG8_BAR; PG8_MMA(1, 0, At, B0); PG8_MMA(1, 1, At, B1); PG8_BAR; PG8_SCHED;
            } else {
            PG8_GOFF(1, ui); PG8_LDB(B0, 0, 0); PG8_LDB(B1, 0, 1); PG8_SCHED; PG8_LDA2(At, 0, 0, 0); PG8_STAGE_A(PG8_SA(1, 1), a1, 1);
            PG8_WAIT_V(8); PG8_WAIT_L(0); PG8_BAR; PG8_MMA2(0, At, 0); PG8_BAR; PG8_SCHED;
            PG8_LDA2(At, 0, 0, 2); PG8_WAIT_L(0); PG8_BAR; PG8_MMA2(0, At, 2); PG8_BAR; PG8_SCHED;
            PG8_GOFF(0, un); PG8_LDA2(At, 0, 1, 0); PG8_STAGE_B(PG8_SB(0, 0), b2); PG8_STAGE_B(PG8_SB(0, 1), b2 + hstep); PG8_STAGE_A(PG8_SA(0, 0), a2, 0);
            PG8_WAIT_V(8); PG8_WAIT_L(0); PG8_BAR; PG8_MMA2(1, At, 0); PG8_BAR; PG8_SCHED;
            PG8_LDA2(At, 0, 1, 2); PG8_WAIT_L(0); PG8_BAR; PG8_MMA2(1, At, 2); PG8_BAR; PG8_SCHED;
            PG8_GOFF(1, un); PG8_LDB(B0, 1, 0); PG8_LDB(B1, 1, 1); PG8_SCHED; PG8_LDA2(At, 1, 0, 0); PG8_STAGE_A(PG8_SA(0, 1), a2, 1);
            PG8_WAIT_V(8); PG8_WAIT_L(0); PG8_BAR; PG8_MMA2(0, At, 0); PG8_BAR; PG8_SCHED;
            PG8_LDA2(At, 1, 0, 2); PG8_WAIT_L(0); PG8_BAR; PG8_MMA2(0, At, 2); PG8_BAR; PG8_SCHED;
            PG8_GOFF(0, un); PG8_LDA2(At, 1, 1, 0); PG8_STAGE_B(PG8_SB(1, 0), b3); PG8_STAGE_B(PG8_SB(1, 1), b3 + hstep); PG8_STAGE_A(PG8_SA(1, 0), a3, 0);
            PG8_WAIT_V(8); PG8_WAIT_L(0); PG8_BAR; PG8_MMA2(1, At, 0); PG8_BAR; PG8_SCHED;
            PG8_LDA2(At, 1, 1, 2); PG8_WAIT_L(0); PG8_BAR; PG8_MMA2(1, At, 2); PG8_BAR; PG8_SCHED;
            }
        }
        if (wr == 0) PG8_BAR;
        E(acc, cur, wr, wc, fr, fq);
        if (!has_next) break;
#pragma unroll
        for (int a = 0; a < 2; ++a)
#pragma unroll
            for (int b = 0; b < 2; ++b)
#pragma unroll
                for (int m = 0; m < 4; ++m)
#pragma unroll
                    for (int n = 0; n < 2; ++n) acc[a][b][m][n] = (f32x4){0.f, 0.f, 0.f, 0.f};
        cur = nxt; cA = nA; cB = nB; ++ui;
        if (wr == 1) PG8_BAR;
    }
    PG8_WAIT_V(0);
    PG8_BAR;
#undef PG8_SA
#undef PG8_SB
#undef PG8_STAGE_A
#undef PG8_STAGE_B
#undef PG8_LDA
#undef PG8_LD8
#undef PG8_LDA2
#undef PG8_MMA2
#undef PG8_LDB
#undef PG8_MMA
#undef PG8_WAIT_V
#undef PG8_WAIT_L
#undef PG8_BAR
#undef PG8_SCHED
#undef PG8_GOFF
#undef PG8_VOFF
#undef PG8_ROWA
}
}

struct Args { const float* in[25]; float* out; unsigned char* ws; int ph_lo, ph_hi; };
struct Frame {
    LAS unsigned char* lds; int tid, lane, wave, G, bx;
    unsigned char* ws; unsigned* ctl;
};
enum { I_X = 0, I_C, I_CTX, I_C_CTX, I_ADA_W, I_ADA_B, I_PRE_MIX, I_POST_MIX, I_PRE_FFN, I_POST_FFN, I_W_IN, I_DEC_F, I_DEC_B, I_GN_W, I_CONV_W, I_CONV_B, I_LN_W, I_LN_B, I_W_OUT,
       I_ROUTER_W, I_ROUTER_B, I_W1, I_B1, I_W2, I_B2, I_OUT };
__device__ __forceinline__ const float* ldp(const Frame& F, int k) {
    const unsigned long long v = *(const LAS unsigned long long*)(F.lds + PTAB_OFF + 8 * k);
    const unsigned lo = __builtin_amdgcn_readfirstlane((unsigned)v), hi = __builtin_amdgcn_readfirstlane((unsigned)(v >> 32));
    return (const float*)(const __attribute__((address_space(1))) float*)(((unsigned long long)hi << 32) | lo); }
__device__ __forceinline__ float* ldp_out(const Frame& F) { return (float*)ldp(F, I_OUT); }

__device__ __forceinline__ int dest_row(int kind, int n) {
    if (kind == 0) return n;
    if (kind == 3) return (n & ~127) + slot128(n & 127);
    if (kind == 4) { const int c = n - 4096, ch = c & 1023, second = c >> 10; return 256 * (ch >> 7) + 128 * second + slot128(ch & 127); }
    if (kind == 2) { const int ch = n & 2047, second = n >> 11; return 256 * (ch >> 7) + 128 * second + slot128(ch & 127); }
    if (n < 2048) { const int base = n & ~1023, c = n & 1023, head = c >> 7, j = c & 127, pnl = head >> 1, bj = head & 1, nn = j >> 6, jj = j & 63;
        return base + 256 * pnl + 128 * bj + 32 * (jj >> 4) + 16 * nn + 4 * ((jj >> 2) & 3) + (jj & 3); }
    if (n < 4096) return (n & ~127) + slot128(n & 127);
    { const int c = n - 4096, ch = c & 1023, second = c >> 10; return 4096 + 256 * (ch >> 7) + 128 * second + slot128(ch & 127); }
}
struct CvtTile { const float* src; unsigned char* dst; int ldn, rowbytes, k0, n0, kind; };
template <bool FP8> __device__ __forceinline__ CvtTile cvt_decode(const Frame& F, const Args& A, int t) {
    CvtTile c;
    if constexpr (!FP8) {
        if (t < 32 * 16) { const int kt = t / 16, ntl = t % 16;                                  c.src = ldp(F, I_W_IN); c.dst = F.ws + WS_WIN; c.ldn = DIN; c.rowbytes = DM * 2; c.k0 = kt * 64; c.n0 = ntl * 256; c.kind = 1; }
        else { const int q = t - 32 * 16, kt = q / 8, ntl = q % 8; c.src = ldp(F, I_W_OUT); c.dst = F.ws + WS_WOUT; c.ldn = DM; c.rowbytes = DM * 2; c.k0 = kt * 64; c.n0 = ntl * 256; c.kind = 3; }
    } else {
        if (t < NE * 256) { const int e = t >> 8, r = t & 255, ntl = r >> 4, kt = r & 15;       c.src = ldp(F, I_W1) + (size_t)e * DM * 2 * DFF; c.dst = F.ws + WS_W1 + (size_t)e * 2 * DFF * DM; c.ldn = 2 * DFF; c.rowbytes = DM; c.k0 = kt * 128; c.n0 = ntl * 256; c.kind = 2; }
        else if (t < NE * 256 + NE * 128) { const int q = t - NE * 256, e = q >> 7, r = q & 127, ntl = r >> 4, kt = r & 15; c.src = ldp(F, I_W2) + (size_t)e * DFF * DM; c.dst = F.ws + WS_W2 + (size_t)e * DM * DFF; c.ldn = DM; c.rowbytes = DFF; c.k0 = kt * 128; c.n0 = ntl * 256; c.kind = 3; }
        else if (t < NE * 384 + 128) { const int q = t - NE * 384, ntl = q >> 4, kt = q & 15;      c.src = ldp(F, I_W_OUT); c.dst = F.ws + WS_WOUT; c.ldn = DM; c.rowbytes = DM; c.k0 = kt * 128; c.n0 = ntl * 256; c.kind = 3; }
        else { const int q = t - (NE * 384 + 128), ntl = q >> 4, kt = q & 15;                      c.src = ldp(F, I_W_IN); c.dst = F.ws + WS_WIN8; c.ldn = DIN; c.rowbytes = DM; c.k0 = kt * 128; c.n0 = 4096 + ntl * 256; c.kind = 4; }
    }
    return c;
}
template <bool FP8> __device__ __forceinline__ void cvt_tiles(const Frame& F, const Args& A, int t0, int tstride, int tend) {
    constexpr int RPB = FP8 ? 16 : 8;
    LAS unsigned* T = (LAS unsigned*)F.lds;
    const int nq = F.tid & 63, kb = F.tid >> 6;
    f32x4 va[RPB], vb[RPB];
#define CVT_ISSUE(v, t_) do { if ((t_) < tend) { const CvtTile _c = cvt_decode<FP8>(F, A, (t_)); const float* _s = _c.src + (size_t)(_c.k0 + RPB * kb) * _c.ldn + _c.n0 + 4 * nq; \
        _Pragma("unroll") for (int r = 0; r < RPB; ++r) v[r] = __builtin_nontemporal_load((const f32x4*)(_s + (size_t)r * _c.ldn)); } } while (0)
#define CVT_PROCESS(v, t_, tnext_) do { const CvtTile _c = cvt_decode<FP8>(F, A, (t_)); \
        _Pragma("unroll") for (int g = 0; g < 4; ++g) _Pragma("unroll") for (int i = 0; i < 4; ++i) { unsigned u; \
            if constexpr (FP8) u = cvt4_fp8(v[4 * g][i] * FP8_BS, v[4 * g + 1][i] * FP8_BS, v[4 * g + 2][i] * FP8_BS, v[4 * g + 3][i] * FP8_BS); \
            else u = cvt_pk_bf16(v[2 * g][i], v[2 * g + 1][i]); \
            T[(4 * nq + i) * 33 + 4 * kb + g] = u; } \
        __syncthreads(); \
        CVT_ISSUE(v, (tnext_)); \
        { const int ch = F.tid & 7; \
        _Pragma("unroll") for (int j = 0; j < 4; ++j) { const int row = (F.tid >> 3) + 64 * j; \
            u32x4 o; o.x = T[row * 33 + 4 * ch]; o.y = T[row * 33 + 4 * ch + 1]; o.z = T[row * 33 + 4 * ch + 2]; o.w = T[row * 33 + 4 * ch + 3]; \
            const int drow = dest_row(_c.kind, _c.n0 + row); \
            u32x4* _p = (u32x4*)(_c.dst + (size_t)drow * _c.rowbytes + (size_t)_c.k0 * (FP8 ? 1 : 2) + 16 * ch); \
            if (_c.kind == 3 && FP8) *_p = o; else __builtin_nontemporal_store(o, _p); } } \
        __syncthreads(); } while (0)
    int t = t0; if (t >= tend) return;
    CVT_ISSUE(va, t); CVT_ISSUE(vb, t + tstride);
    for (;;) {
        CVT_PROCESS(va, t, t + 2 * tstride); t += tstride; if (t >= tend) break;
        CVT_PROCESS(vb, t, t + 2 * tstride); t += tstride; if (t >= tend) break;
    }
#undef CVT_ISSUE
#undef CVT_PROCESS
}
template <bool FP8> __device__ __forceinline__ void cvt_tiles_tp(const Frame& F, const Args& A, int t0, int tstride, int tend) {
    constexpr int RPB = FP8 ? 16 : 8;
    const int g = F.lane >> 3, j = F.lane & 7;
    f32x4 va[RPB], vb[RPB];
#define TP_ISSUE(v, t_) do { if ((t_) < tend) { const CvtTile _c = cvt_decode<FP8>(F, A, (t_)); const float* _s = _c.src + (size_t)(_c.k0 + RPB * g) * _c.ldn + _c.n0 + 32 * F.wave + 4 * j; \
        _Pragma("unroll") for (int r = 0; r < RPB; ++r) v[r] = __builtin_nontemporal_load((const f32x4*)(_s + (size_t)r * _c.ldn)); } } while (0)
#define TP_FINISH(v, t_) do { const CvtTile _c = cvt_decode<FP8>(F, A, (t_)); \
        _Pragma("unroll") for (int i = 0; i < 4; ++i) { u32x4 o; \
            if constexpr (FP8) { o.x = cvt4_fp8(v[0][i] * FP8_BS, v[1][i] * FP8_BS, v[2][i] * FP8_BS, v[3][i] * FP8_BS); o.y = cvt4_fp8(v[4][i] * FP8_BS, v[5][i] * FP8_BS, v[6][i] * FP8_BS, v[7][i] * FP8_BS); \
                o.z = cvt4_fp8(v[8 % RPB][i] * FP8_BS, v[9 % RPB][i] * FP8_BS, v[10 % RPB][i] * FP8_BS, v[11 % RPB][i] * FP8_BS); o.w = cvt4_fp8(v[12 % RPB][i] * FP8_BS, v[13 % RPB][i] * FP8_BS, v[14 % RPB][i] * FP8_BS, v[15 % RPB][i] * FP8_BS); } \
            else { o.x = cvt_pk_bf16(v[0][i], v[1][i]); o.y = cvt_pk_bf16(v[2][i], v[3][i]); o.z = cvt_pk_bf16(v[4][i], v[5][i]); o.w = cvt_pk_bf16(v[6][i], v[7][i]); } \
            const int drow = dest_row(_c.kind, _c.n0 + 32 * F.wave + 4 * j + i); \
            u32x4* _p = (u32x4*)(_c.dst + (size_t)drow * _c.rowbytes + (size_t)(_c.k0 + RPB * g) * (FP8 ? 1 : 2)); \
            if (_c.kind == 3 && FP8) *_p = o; else __builtin_nontemporal_store(o, _p); } } while (0)
    int t = t0; if (t >= tend) return;
    TP_ISSUE(va, t); TP_ISSUE(vb, t + tstride);
    for (;;) {
        TP_FINISH(va, t); TP_ISSUE(va, t + 2 * tstride); t += tstride; if (t >= tend) break;
        TP_FINISH(vb, t); TP_ISSUE(vb, t + 2 * tstride); t += tstride; if (t >= tend) break;
    }
#undef TP_ISSUE
#undef TP_FINISH
}
__device__ __forceinline__ void p0_prologue(const Frame& F, const Args& A) {
    constexpr int NADA = 6 * DM / 64;
    if (F.bx < NADA) {
        LAS float* tab = (LAS float*)F.lds;
        LAS float* red = (LAS float*)(F.lds + 98304);
        { const float* cp = ldp(F, I_C); const float* cc = ldp(F, I_C_CTX);
          float v[4][9];
#pragma unroll
          for (int j = 0; j < 4; ++j) { const int k = F.tid + 512 * j;
#pragma unroll
              for (int r = 0; r < 8; ++r) v[j][r] = cp[r * DM + k];
              v[j][8] = cc[k]; }
#pragma unroll
          for (int j = 0; j < 4; ++j) { const int k = F.tid + 512 * j;
              *(LAS f32x4*)(tab + k * 12) = (f32x4){siluf_(v[j][0]), siluf_(v[j][1]), siluf_(v[j][2]), siluf_(v[j][3])};
              *(LAS f32x4*)(tab + k * 12 + 4) = (f32x4){siluf_(v[j][4]), siluf_(v[j][5]), siluf_(v[j][6]), siluf_(v[j][7])};
              tab[k * 12 + 8] = siluf_(v[j][8]); } }
        __syncthreads();
        for (int u = F.bx; u < NADA; u += F.G) {
            const int col = u * 64 + F.lane; float acc[9];
#pragma unroll
            for (int r = 0; r < 9; ++r) acc[r] = 0.f;
            const float* wp = ldp(F, I_ADA_W) + (size_t)(F.wave * 256) * (6 * DM) + col;
            for (int k0 = 0; k0 < 256; k0 += 32) { float av[32];
#pragma unroll
                for (int j = 0; j < 32; ++j) av[j] = __builtin_nontemporal_load(wp + (size_t)(k0 + j) * (6 * DM));
#pragma unroll
                for (int j = 0; j < 32; ++j) { const float a = av[j]; const int k = F.wave * 256 + k0 + j;
                    const f32x4 s0 = *(const LAS f32x4*)(tab + k * 12), s1 = *(const LAS f32x4*)(tab + k * 12 + 4), s2 = *(const LAS f32x4*)(tab + k * 12 + 8);
                    acc[0] += a * s0[0]; acc[1] += a * s0[1]; acc[2] += a * s0[2]; acc[3] += a * s0[3]; acc[4] += a * s1[0]; acc[5] += a * s1[1]; acc[6] += a * s1[2]; acc[7] += a * s1[3]; acc[8] += a * s2[0]; } }
#pragma unroll
            for (int r = 0; r < 9; ++r) red[(F.wave * 9 + r) * 64 + F.lane] = acc[r];
            __syncthreads();
            for (int idx = F.tid; idx < 9 * 64; idx += 512) { const int r = idx >> 6, l = idx & 63; float s = 0.f;
#pragma unroll
                for (int w = 0; w < 8; ++w) s += red[(w * 9 + r) * 64 + l];
                ((float*)(F.ws + WS_MOD))[r * (6 * DM) + u * 64 + l] = s + ldp(F, I_ADA_B)[u * 64 + l]; }
            __syncthreads();
        }
    }
    for (int idx = F.bx * 512 + F.tid; idx < NE * DM; idx += F.G * 512) { const int e = idx / DM, k = idx % DM; ((bf16_t*)(F.ws + WS_RWT))[idx] = (bf16_t)(cvt_pk_bf16(ldp(F, I_ROUTER_W)[k * NE + e], 0.f) & 0xffffu); }
    if (F.G == 256) { if (F.bx < NADA) cvt_tiles_tp<false>(F, A, F.bx, NADA, 2 * NADA);
        else { cvt_tiles_tp<false>(F, A, 2 * NADA + (F.bx - NADA), 256 - NADA, 32 * 16); cvt_tiles_tp<true>(F, A, NE * 384 + (F.bx - NADA), 256 - NADA, NE * 384 + 256); } }
    else { cvt_tiles<false>(F, A, F.bx, F.G, 32 * 16); cvt_tiles<true>(F, A, NE * 384 + F.bx, F.G, NE * 384 + 256); }
}

__device__ __forceinline__ void p1_norm_mod(const Frame& F, const Args& A) {
    const float* mod = (const float*)(F.ws + WS_MOD);
    constexpr int NROWS = NTOK + NCTX;
    for (int row = F.bx * 8 + F.wave; row < NROWS; row += F.G * 8) {
        const bool isctx = row >= NTOK; const int r2 = isctx ? row - NTOK : row;
        const float* src = isctx ? ldp(F, I_CTX) + (size_t)r2 * DM : ldp(F, I_X) + (size_t)r2 * DM;
        bf16_t* dst = isctx ? (bf16_t*)(F.ws + WS_HCTX) + (size_t)r2 * DM : (bf16_t*)(F.ws + WS_HLAT) + (size_t)r2 * DM;
        const float* mrow = mod + (size_t)(isctx ? 8 : (r2 / SEQ)) * (6 * DM);
        f32x4 v[8]; float ss = 0.f;
#pragma unroll
        for (int j = 0; j < 8; ++j) { v[j] = __builtin_nontemporal_load((const f32x4*)(src + 4 * F.lane + 256 * j)); ss += v[j][0] * v[j][0] + v[j][1] * v[j][1] + v[j][2] * v[j][2] + v[j][3] * v[j][3]; }
        ss = wave_sum(ss); const float rstd = rsqrtf(ss * (1.0f / DM) + EPS);
#pragma unroll
        for (int j = 0; j < 8; ++j) { const int col = 4 * F.lane + 256 * j;
            const f32x4 w = *(const f32x4*)(ldp(F, I_PRE_MIX) + col), sh = *(const f32x4*)(mrow + col), sc = *(const f32x4*)(mrow + DM + col);
            f32x4 y;
#pragma unroll
            for (int i = 0; i < 4; ++i) y[i] = v[j][i] * rstd * w[i] * (1.0f + sc[i]) + sh[i];
            u32x2 o; o.x = cvt_pk_bf16(y[0], y[1]); o.y = cvt_pk_bf16(y[2], y[3]); *(u32x2*)(dst + col) = o;
            if (!isctx) *(unsigned*)(F.ws + WS_H8 + (size_t)r2 * DM + col) = cvt4_fp8(y[0] * FP8_AS, y[1] * FP8_AS, y[2] * FP8_AS, y[3] * FP8_AS); }
    }
}

struct SchedIn {
    int G, c, r0, nr; bool f8;
    __device__ __forceinline__ bool next(int i_, pg8::Unit& u) const {
        const int i = r0 + i_;
        const int nN = f8 ? 8 : 16, NLAT = 64 * nN; const long L = (long)i * G + c; int pm = 0, pn = 0, aux = 0; bool ok;
        if (i_ >= nr) { u.pm = 0; u.pn = 0; u.aux = 0; return false; }
        if (L < NLAT) { ok = pg8::static_order(64, nN, G, c, i, pm, pn); if (f8) pn += 16; }
        else if (!f8) { const int q = (int)(L - NLAT); ok = q < 64; aux = 1; pm = q & 7; pn = 4 + (q >> 3); }
        else ok = false;
        u.pm = pm; u.pn = pn; u.aux = aux; return ok; }
    __device__ __forceinline__ unsigned abase(const pg8::Unit& u) const { return f8 ? (unsigned)WS_H8 + (unsigned)u.pm * (256u * DM) : (unsigned)WS_HLAT + (unsigned)u.aux * (unsigned)(WS_HCTX - WS_HLAT) + (unsigned)u.pm * (256u * DM * 2u); }
    __device__ __forceinline__ unsigned bbase(const pg8::Unit& u) const { return f8 ? (unsigned)WS_WIN8 + (unsigned)(u.pn - 16) * (256u * DM) : (unsigned)WS_WIN + (unsigned)u.pn * (256u * DM * 2u); }
};
struct EpiGlu8 { unsigned char* ws;
    __device__ __forceinline__ void operator()(const f32x4 (&acc)[2][2][4][2], const pg8::Unit& u, int wr, int wc, int fr_, int fq_) const {
        const int ln_ = get_lane(); const int fr = ln_ & 15, fq = ln_ >> 4; (void)fr_; (void)fq_;
        const int row0 = u.pm * 256 + wr * 64 + fr, tl = u.pn - 16; bf16_t* base = (bf16_t*)(ws + WS_U);
#pragma unroll
        for (int ai = 0; ai < 2; ++ai)
#pragma unroll
            for (int m = 0; m < 4; ++m) { const int row = row0 + ai * 128 + m * 16; float o[8];
#pragma unroll
                for (int n = 0; n < 2; ++n)
#pragma unroll
                    for (int i = 0; i < 4; ++i) o[4 * n + i] = (acc[ai][0][m][n][i] * FP8_DESCALE) * sigmoidf_(acc[ai][1][m][n][i] * FP8_DESCALE);
                u32x4 w; w.x = cvt_pk_bf16(o[0], o[1]); w.y = cvt_pk_bf16(o[2], o[3]); w.z = cvt_pk_bf16(o[4], o[5]); w.w = cvt_pk_bf16(o[6], o[7]);
                *(u32x4*)(base + (unsigned)(row * DCONV + 128 * tl + 32 * wc + 8 * fq)) = w; } } };
struct EpiIn {
    unsigned char* ws;
    __device__ __forceinline__ void operator()(const f32x4 (&acc)[2][2][4][2], const pg8::Unit& u, int wr, int wc, int fr_, int fq_) const {
        const int ln_ = get_lane(); const int fr = ln_ & 15, fq = ln_ >> 4; (void)fr_; (void)fq_;
        const int row0 = u.pm * 256 + wr * 64 + fr;
        if (u.pn < 8) {
            const bool isq = u.pn < 4; const int pnl = u.pn & 3;
            bf16_t* base = (bf16_t*)(ws + (u.aux ? WS_KC : (isq ? WS_Q : WS_K)));
            const float scl = isq ? 0.08838834764831845f : 1.0f;
            const int j0 = 16 * wc + 4 * fq;
            float inv[4];
#pragma unroll
            for (int i = 0; i < 4; ++i) inv[i] = exp2f(-(float)(j0 + i) * (13.287712379549449f / 64.0f));
#pragma unroll
            for (int ai = 0; ai < 2; ++ai)
#pragma unroll
                for (int m = 0; m < 4; ++m) { const int row = row0 + ai * 128 + m * 16;
                    const float pos = u.aux ? (float)(row & (CTXL - 1)) : (float)(CTXL + (row & (SEQ - 1)));
                    f32x4 cs, sn;
#pragma unroll
                    for (int i = 0; i < 4; ++i) { float t = pos * inv[i] * 0.15915494309189535f; t = t - rintf(t); sn[i] = __builtin_amdgcn_sinf(t) * scl; cs[i] = __builtin_amdgcn_cosf(t) * scl; }
#pragma unroll
                    for (int bj = 0; bj < 2; ++bj) { const f32x4 t1 = acc[ai][bj][m][0], t2 = acc[ai][bj][m][1];
                        const f32x4 o1 = t1 * cs - t2 * sn, o2 = t1 * sn + t2 * cs;
                        bf16_t* p = base + (unsigned)(row * DRET + 128 * (2 * pnl + bj) + j0);
                        u32x2 w1; w1.x = cvt_pk_bf16(o1[0], o1[1]); w1.y = cvt_pk_bf16(o1[2], o1[3]); *(u32x2*)p = w1;
                        u32x2 w2; w2.x = cvt_pk_bf16(o2[0], o2[1]); w2.y = cvt_pk_bf16(o2[2], o2[3]); *(u32x2*)(p + 64) = w2; } }
        } else if (u.pn < 16) {
            const bool isv = u.pn < 12; const int pnl = u.pn & 3;
            bf16_t* base = (bf16_t*)(ws + (u.aux ? WS_VC : (isv ? WS_V : WS_G)));
#pragma unroll
            for (int ai = 0; ai < 2; ++ai)
#pragma unroll
                for (int m = 0; m < 4; ++m) { const int row = row0 + ai * 128 + m * 16;
#pragma unroll
                    for (int bj = 0; bj < 2; ++bj) { f32x4 a = acc[ai][bj][m][0], b = acc[ai][bj][m][1];
                        if (!isv) {
#pragma unroll
                            for (int i = 0; i < 4; ++i) { a[i] = siluf_(a[i]); b[i] = siluf_(b[i]); } }
                        u32x4 w; w.x = cvt_pk_bf16(a[0], a[1]); w.y = cvt_pk_bf16(a[2], a[3]); w.z = cvt_pk_bf16(b[0], b[1]); w.w = cvt_pk_bf16(b[2], b[3]);
                        *(u32x4*)(base + (unsigned)(row * DRET + 256 * pnl + 128 * bj + 32 * wc + 8 * fq)) = w; } }
        }
    }
};

constexpr int IMGP = 272, IMGB = 128 * IMGP;
__device__ __forceinline__ unsigned img_row_base(unsigned lane) { return (lane & 15) * IMGP + 16 * (lane >> 4); }
__device__ __forceinline__ unsigned img_tr_base(unsigned lane) { return (8 * (lane >> 4) + ((lane & 15) >> 2)) * IMGP + 8 * (lane & 3); }
__device__ __forceinline__ bf16x8 tr_frag(const LAS unsigned char* img, unsigned trb, int c, int ks) {
    const s16x4 a = __builtin_amdgcn_ds_read_tr16_b64_v4i16((LAS s16x4*)(img + trb + ks * 32 * IMGP + c * 32));
    const s16x4 b = __builtin_amdgcn_ds_read_tr16_b64_v4i16((LAS s16x4*)(img + trb + ks * 32 * IMGP + 4 * IMGP + c * 32));
    bf16x8 r; r[0] = a[0]; r[1] = a[1]; r[2] = a[2]; r[3] = a[3]; r[4] = b[0]; r[5] = b[1]; r[6] = b[2]; r[7] = b[3]; return r; }

__device__ __forceinline__ void p3_state_unit(const Frame& F, const Args& A, int unit) {
    const int eh = unit & 1, dir = (unit >> 1) & 1, bh = unit >> 2, b = bh >> 3, h = bh & 7;
    const float lg = log_sigmoid_(dir ? ldp(F, I_DEC_B)[h] : ldp(F, I_DEC_F)[h]);
    const float dchunk = __expf(lg * (float)CHUNK);
    static_assert(4 * IMGB <= RING_BYTES, "state scan LDS"); LAS unsigned char* Kimg = F.lds;
    bf16_t* ST = (bf16_t*)(F.ws + (dir ? WS_SB : WS_SF)) + (size_t)bh * NCHUNK * HD * HD;
    const bf16_t* kl = (const bf16_t*)(F.ws + WS_K); const bf16_t* vl = (const bf16_t*)(F.ws + WS_V);
    const bf16_t* kc = (const bf16_t*)(F.ws + WS_KC); const bf16_t* vc = (const bf16_t*)(F.ws + WS_VC);
    f32x4 acc[4];
#pragma unroll
    for (int c = 0; c < 4; ++c) acc[c] = (f32x4){0.f, 0.f, 0.f, 0.f};
    int lane = F.lane; const int w = F.wave;
    asm volatile("" : "+v"(lane));
    const unsigned trb = img_tr_base((unsigned)lane);
    u32x4 kreg[4], vreg[2];
#define P3_LOAD(step_) do { const int _s = (step_); const bool _ic = _s < 2; const int _ci = _ic ? (dir ? 1 - _s : _s) : (dir ? 17 - _s : _s - 2); \
        const size_t _t0 = _ic ? (size_t)b * CTXL + _ci * CHUNK : (size_t)b * SEQ + _ci * CHUNK; \
        const bf16_t* _ks = (_ic ? kc : kl) + _t0 * DRET + h * HD; const bf16_t* _vs = (_ic ? vc : vl) + _t0 * DRET + h * HD + 64 * eh; \
        _Pragma("unroll") for (int j = 0; j < 4; ++j) { const int idx = F.tid + 512 * j; kreg[j] = *(const u32x4*)(_ks + (size_t)(idx >> 4) * DRET + (idx & 15) * 8); } \
        _Pragma("unroll") for (int j = 0; j < 2; ++j) { const int idx = F.tid + 512 * j; vreg[j] = *(const u32x4*)(_vs + (size_t)(idx >> 3) * DRET + (idx & 7) * 8); } } while (0)
#define P3_WRITE(step_) do { LAS unsigned char* _K = Kimg + ((step_) & 1) * 2 * IMGB; LAS unsigned char* _V = _K + IMGB; \
        _Pragma("unroll") for (int j = 0; j < 4; ++j) { const int idx = F.tid + 512 * j; *(LAS u32x4*)(_K + (idx >> 4) * IMGP + (idx & 15) * 16) = kreg[j]; } \
        _Pragma("unroll") for (int j = 0; j < 2; ++j) { const int idx = F.tid + 512 * j, row = idx >> 3, ch = 8 * eh + (idx & 7); const u32x4 vv = vreg[j]; \
            const float wt = __expf(lg * (float)(dir ? row : (CHUNK - 1 - row)));                \
            u32x4 o; o.x = cvt_pk_bf16(bf_lo(vv.x) * wt, bf_hi(vv.x) * wt); o.y = cvt_pk_bf16(bf_lo(vv.y) * wt, bf_hi(vv.y) * wt); \
            o.z = cvt_pk_bf16(bf_lo(vv.z) * wt, bf_hi(vv.z) * wt); o.w = cvt_pk_bf16(bf_lo(vv.w) * wt, bf_hi(vv.w) * wt); \
            *(LAS u32x4*)(_V + row * IMGP + ch * 16) = o; } } while (0)
    __syncthreads();
    P3_LOAD(0); P3_WRITE(0); P3_LOAD(1);
    __syncthreads();
    for (int step = 0; step < 18; ++step) {
        const bool isctx = step < 2; const int ci = isctx ? (dir ? 1 - step : step) : (dir ? 17 - step : step - 2);
        if (!isctx) {
#pragma unroll
            for (int c = 0; c < 4; ++c) { const int e = 64 * eh + 16 * c + (lane & 15), d0 = 16 * w + 4 * (lane >> 4);
                u32x2 o; o.x = cvt_pk_bf16(acc[c][0], acc[c][1]); o.y = cvt_pk_bf16(acc[c][2], acc[c][3]);
                *(u32x2*)(ST + ((size_t)ci * HD + e) * HD + d0) = o; }
            if (step == 17) break;
        }
        if (step + 1 < 17) { P3_WRITE(step + 1); if (step + 2 < 17) P3_LOAD(step + 2); }
        { LAS unsigned char* Kc = Kimg + (step & 1) * 2 * IMGB; LAS unsigned char* Vc = Kc + IMGB;
#pragma unroll
        for (int c = 0; c < 4; ++c) { acc[c][0] *= dchunk; acc[c][1] *= dchunk; acc[c][2] *= dchunk; acc[c][3] *= dchunk; }
#pragma unroll
        for (int ks = 0; ks < 4; ++ks) { const bf16x8 af = tr_frag(Kc, trb, w, ks);
#pragma unroll
            for (int c = 0; c < 4; ++c) { const bf16x8 bfr = tr_frag(Vc, trb, 4 * eh + c, ks);
                acc[c] = __builtin_amdgcn_mfma_f32_16x16x32_bf16(af, bfr, acc[c], 0, 0, 0); } } }
        __syncthreads();
    }
#undef P3_WRITE
#undef P3_LOAD
    __syncthreads();
}

__device__ __forceinline__ void p3_conv_unit(const Frame& F, const Args& A, int sq) {
    LAS bf16_t* T = (LAS bf16_t*)F.lds;
    const size_t tok0 = (size_t)sq * GRIDW;
    const bf16_t* usrc = (const bf16_t*)(F.ws + WS_U) + tok0 * DCONV;
    __syncthreads();
#pragma unroll
    for (int j = 0; j < 16; ++j) { const int idx = F.tid + 512 * j; *(LAS u32x4*)(F.lds + idx * 16) = __builtin_nontemporal_load((const u32x4*)(usrc + (size_t)idx * 8)); }
    __syncthreads();
    {
        const int ch = 2 * F.tid;
        f32x2 wv[CONVW];
#pragma unroll
        for (int t = 0; t < CONVW; ++t) wv[t] = *(const f32x2*)(ldp(F, I_CONV_W) + t * DCONV + ch);
        const f32x2 bias = *(const f32x2*)(ldp(F, I_CONV_B) + ch);
        f32x2 prev[16];
#pragma unroll
        for (int i = 0; i < 16; ++i) prev[i] = (f32x2){0.f, 0.f};
        for (int cb = 0; cb < 4; ++cb) {
            const int p0 = cb * 16; f32x2 a[16];
#pragma unroll
            for (int i = 0; i < 16; ++i) a[i] = bias;
#pragma unroll
            for (int qb = 0; qb < 6; ++qb) { f32x2 xin[8];
#pragma unroll
                for (int k = 0; k < 8; ++k) { const int qq = qb * 8 + k, q = p0 - CONVP + qq; const bool ok = (qq < 46) && (q >= 0) && (q < GRIDW);
                    const unsigned uu = ok ? *(const LAS unsigned*)(T + (ok ? q : 0) * DCONV + ch) : 0u; xin[k] = (f32x2){bf_lo(uu), bf_hi(uu)}; }
#pragma unroll
                for (int k = 0; k < 8; ++k) { const int qq = qb * 8 + k;
#pragma unroll
                    for (int i = 0; i < 16; ++i) { const int tap = qq - i;
                        if (qq < 46 && tap >= 0 && tap < CONVW) a[i] += wv[tap] * xin[k]; } }
                asm volatile("" ::: "memory"); }
            if (cb > 0) {
#pragma unroll
                for (int i = 0; i < 16; ++i) *(LAS unsigned*)(T + (p0 - 16 + i) * DCONV + ch) = cvt_pk_bf16(prev[i][0], prev[i][1]); }
#pragma unroll
            for (int i = 0; i < 16; ++i) prev[i] = a[i];
        }
#pragma unroll
        for (int i = 0; i < 16; ++i) *(LAS unsigned*)(T + (48 + i) * DCONV + ch) = cvt_pk_bf16(prev[i][0], prev[i][1]);
    }
    __syncthreads();
    float lw[16], lb[16];
#pragma unroll
    for (int i = 0; i < 16; ++i) { lw[i] = ldp(F, I_LN_W)[16 * F.lane + i]; lb[i] = ldp(F, I_LN_B)[16 * F.lane + i]; }
    unsigned char* ydst = F.ws + WS_Y;
    for (int p = F.wave; p < GRIDW; p += 8) {
        const u32x4 r0 = *(const LAS u32x4*)(F.lds + p * 2048 + F.lane * 32), r1 = *(const LAS u32x4*)(F.lds + p * 2048 + F.lane * 32 + 16);
        float v[16]; const unsigned rr[8] = {r0.x, r0.y, r0.z, r0.w, r1.x, r1.y, r1.z, r1.w};
#pragma unroll
        for (int i = 0; i < 8; ++i) { v[2 * i] = bf_lo(rr[i]); v[2 * i + 1] = bf_hi(rr[i]); }
        float s = 0.f;
#pragma unroll
        for (int i = 0; i < 16; ++i) s += v[i];
        const float mu = wave_sum(s) * (1.0f / DCONV); float q = 0.f;
#pragma unroll
        for (int i = 0; i < 16; ++i) { const float d = v[i] - mu; q += d * d; }
        const float rstd = rsqrtf(wave_sum(q) * (1.0f / DCONV) + EPS);
        float yv[16];
#pragma unroll
        for (int i = 0; i < 16; ++i) yv[i] = siluf_((v[i] - mu) * rstd * lw[i] + lb[i]) * FP8_AS;
        *(u32x4*)(ydst + (tok0 + p) * DM + DRET + 16 * F.lane) = (u32x4){cvt4_fp8(yv[0], yv[1], yv[2], yv[3]), cvt4_fp8(yv[4], yv[5], yv[6], yv[7]), cvt4_fp8(yv[8], yv[9], yv[10], yv[11]), cvt4_fp8(yv[12], yv[13], yv[14], yv[15])};
    }
    __syncthreads();
}

__device__ __forceinline__ void p4_retention(const Frame& F, const Args& A) {
    static_assert(4 * IMGB <= RING_BYTES, "retention phase LDS");
    const int lane0 = F.lane, w = F.wave;
    LAS unsigned char* Kimg = F.lds; LAS unsigned char* Vimg = F.lds + IMGB; LAS unsigned char* Bimg = F.lds + 2 * IMGB; LAS unsigned char* Pimg = F.lds + 3 * IMGB + w * (16 * IMGP);
    const bf16_t* kall = (const bf16_t*)(F.ws + WS_K); const bf16_t* vall = (const bf16_t*)(F.ws + WS_V); const bf16_t* qall = (const bf16_t*)(F.ws + WS_Q);
    u32x4 kreg[4], vreg[4]; bf16x8 qn[4];
#define P4_LOAD(u_) do { const int _ci = (u_) & 15, _bh = (u_) >> 4; const size_t _o = ((size_t)(_bh >> 3) * SEQ + _ci * CHUNK) * DRET + (_bh & 7) * HD; \
        _Pragma("unroll") for (int j = 0; j < 4; ++j) { const int idx = (w * 64 + lane) + 512 * j; kreg[j] = *(const u32x4*)(kall + _o + (size_t)(idx >> 4) * DRET + (idx & 15) * 8); vreg[j] = *(const u32x4*)(vall + _o + (size_t)(idx >> 4) * DRET + (idx & 15) * 8); } \
        _Pragma("unroll") for (int ks = 0; ks < 4; ++ks) qn[ks] = *(const bf16x8*)(qall + _o + (size_t)(16 * w + (lane & 15)) * DRET + 32 * ks + 8 * (lane >> 4)); } while (0)
    int unit = F.bx;
    { const int lane = lane0; if (unit < 1024) P4_LOAD(unit); }
    for (; unit < 1024; unit += F.G) {
        int lane = lane0; asm volatile("" : "+v"(lane));
        const unsigned rwb = img_row_base((unsigned)lane), trb = img_tr_base((unsigned)lane);
        const int ci = unit & 15, bh = unit >> 4, b = bh >> 3, h = bh & 7;
        const float lgf = log_sigmoid_(ldp(F, I_DEC_F)[h]), lgb = log_sigmoid_(ldp(F, I_DEC_B)[h]);
        const float lf2 = lgf * 1.4426950408889634f, lb2 = lgb * 1.4426950408889634f;
        const size_t tok0 = (size_t)b * SEQ + ci * CHUNK;
        __syncthreads();
#pragma unroll
        for (int j = 0; j < 4; ++j) { const int idx = F.tid + 512 * j; *(LAS u32x4*)(Kimg + (idx >> 4) * IMGP + (idx & 15) * 16) = kreg[j]; *(LAS u32x4*)(Vimg + (idx >> 4) * IMGP + (idx & 15) * 16) = vreg[j]; }
        bf16x8 qf[4];
#pragma unroll
        for (int ks = 0; ks < 4; ++ks) qf[ks] = qn[ks];
        const bf16_t* sfp = (const bf16_t*)(F.ws + WS_SF) + ((size_t)bh * NCHUNK + ci) * HD * HD; const bf16_t* sbp = (const bf16_t*)(F.ws + WS_SB) + ((size_t)bh * NCHUNK + ci) * HD * HD;
        u32x4 sfr[4], sbr[4];
#pragma unroll
        for (int j = 0; j < 4; ++j) { const int idx = F.tid + 512 * j; sfr[j] = __builtin_nontemporal_load((const u32x4*)(sfp + (size_t)idx * 8)); sbr[j] = __builtin_nontemporal_load((const u32x4*)(sbp + (size_t)idx * 8)); }
        __syncthreads();
        const int tl = 16 * w + (lane & 15);
#pragma unroll
        for (int c = 0; c < 8; ++c) { f32x4 sc = (f32x4){0.f, 0.f, 0.f, 0.f};
#pragma unroll
            for (int ks = 0; ks < 4; ++ks) { const bf16x8 kf = *(const LAS bf16x8*)(Kimg + rwb + c * 16 * IMGP + ks * 64); sc = __builtin_amdgcn_mfma_f32_16x16x32_bf16(kf, qf[ks], sc, 0, 0, 0); }
            float p[4];
#pragma unroll
            for (int r = 0; r < 4; ++r) { const int s = 16 * c + 4 * (lane >> 4) + r, dt = tl - s;
                const float df = (dt >= 0) ? __builtin_amdgcn_exp2f(lf2 * (float)dt) : 0.f, db = (dt <= 0) ? __builtin_amdgcn_exp2f(lb2 * (float)(-dt)) : 0.f;
                p[r] = sc[r] * (df + db); }
            u32x2 o; o.x = cvt_pk_bf16(p[0], p[1]); o.y = cvt_pk_bf16(p[2], p[3]);
            *(LAS u32x2*)(Pimg + (lane & 15) * IMGP + 32 * c + 8 * (lane >> 4)) = o; }
        __syncthreads();
#pragma unroll
        for (int j = 0; j < 4; ++j) { const int idx = F.tid + 512 * j; *(LAS u32x4*)(Kimg + (idx >> 4) * IMGP + (idx & 15) * 16) = sfr[j]; *(LAS u32x4*)(Bimg + (idx >> 4) * IMGP + (idx & 15) * 16) = sbr[j]; }
        __syncthreads();
        if (unit + F.G < 1024) P4_LOAD(unit + F.G);
        const bf16_t* gsrc = (const bf16_t*)(F.ws + WS_G) + (tok0 + tl) * DRET + h * HD;
        u32x2 gg[8];
#pragma unroll
        for (int c = 0; c < 8; ++c) gg[c] = __builtin_nontemporal_load((const u32x2*)(gsrc + 16 * c + 4 * (lane >> 4)));
        bf16x8 pf[4];
#pragma unroll
        for (int ks = 0; ks < 4; ++ks) pf[ks] = *(const LAS bf16x8*)(Pimg + rwb + ks * 64);
        const float af = __expf(lgf * (float)(tl + 1)), ab = __expf(lgb * (float)(CHUNK - tl));
        f32x4 o[8];
#pragma unroll
        for (int c = 0; c < 8; ++c) { f32x4 a = (f32x4){0.f, 0.f, 0.f, 0.f}, f = a, g = a;
#pragma unroll
            for (int ks = 0; ks < 4; ++ks) { const bf16x8 vf = tr_frag(Vimg, trb, c, ks); a = __builtin_amdgcn_mfma_f32_16x16x32_bf16(vf, pf[ks], a, 0, 0, 0); }
#pragma unroll
            for (int ks = 0; ks < 4; ++ks) { const bf16x8 s1 = *(const LAS bf16x8*)(Kimg + rwb + c * 16 * IMGP + ks * 64); f = __builtin_amdgcn_mfma_f32_16x16x32_bf16(s1, qf[ks], f, 0, 0, 0); }
#pragma unroll
            for (int ks = 0; ks < 4; ++ks) { const bf16x8 s2 = *(const LAS bf16x8*)(Bimg + rwb + c * 16 * IMGP + ks * 64); g = __builtin_amdgcn_mfma_f32_16x16x32_bf16(s2, qf[ks], g, 0, 0, 0); }
#pragma unroll
            for (int r = 0; r < 4; ++r) o[c][r] = a[r] + af * f[r] + ab * g[r]; }
        float s = 0.f;
#pragma unroll
        for (int c = 0; c < 8; ++c) s += (o[c][0] + o[c][1]) + (o[c][2] + o[c][3]);
        s += __shfl_xor(s, 16); s += __shfl_xor(s, 32);
        const float mu = s * (1.0f / HD); float q2 = 0.f;
#pragma unroll
        for (int c = 0; c < 8; ++c)
#pragma unroll
            for (int r = 0; r < 4; ++r) { const float d = o[c][r] - mu; q2 += d * d; }
        q2 += __shfl_xor(q2, 16); q2 += __shfl_xor(q2, 32);
        const float rstd = rsqrtf(q2 * (1.0f / HD) + GN_EPS);
        unsigned char* ydst = F.ws + WS_Y + (tok0 + tl) * DM + h * HD;
        const float* gnw = ldp(F, I_GN_W) + h * HD;
#pragma unroll
        for (int c = 0; c < 8; ++c) { const int e0 = 16 * c + 4 * (lane >> 4);
            const f32x4 gw = *(const f32x4*)(gnw + e0);
            const float y0 = (o[c][0] - mu) * rstd * gw[0] * bf_lo(gg[c].x), y1 = (o[c][1] - mu) * rstd * gw[1] * bf_hi(gg[c].x), y2 = (o[c][2] - mu) * rstd * gw[2] * bf_lo(gg[c].y), y3 = (o[c][3] - mu) * rstd * gw[3] * bf_hi(gg[c].y);
            *(unsigned*)(ydst + e0) = cvt4_fp8(y0 * FP8_AS, y1 * FP8_AS, y2 * FP8_AS, y3 * FP8_AS); }
    }
#undef P4_LOAD
    __syncthreads();
}

struct SchedDense { unsigned a, bt; int nM, nN, G, c; unsigned RB; int r0, nr;
    __device__ __forceinline__ bool next(int i, pg8::Unit& u) const { u.aux = 0; int pm = 0, pn = 0; const bool ok = (i < nr) && pg8::static_order(nM, nN, G, c, r0 + i, pm, pn); u.pm = pm; u.pn = pn; return ok; }
    __device__ __forceinline__ unsigned abase(const pg8::Unit& u) const { return a + (unsigned)u.pm * 256u * RB; }
    __device__ __forceinline__ unsigned bbase(const pg8::Unit& u) const { return bt + (unsigned)u.pn * 256u * RB; } };
struct EpiBf16 { bf16_t* C; int ldc; float sc;
    __device__ __forceinline__ void operator()(const f32x4 (&acc)[2][2][4][2], const pg8::Unit& u, int wr, int wc, int fr_, int fq_) const {
        const int ln_ = get_lane(); const int fr = ln_ & 15, fq = ln_ >> 4; (void)fr_; (void)fq_;
        const int row0 = u.pm * 256 + wr * 64 + fr, col0 = u.pn * 256 + wc * 32 + 8 * fq;
#pragma unroll
        for (int ai = 0; ai < 2; ++ai)
#pragma unroll
            for (int m = 0; m < 4; ++m) { bf16_t* rowp = C + (unsigned)((row0 + ai * 128 + m * 16) * ldc + col0);
#pragma unroll
                for (int bj = 0; bj < 2; ++bj) { const f32x4 a = acc[ai][bj][m][0] * sc, b = acc[ai][bj][m][1] * sc;
                    u32x4 w; w.x = cvt_pk_bf16(a[0], a[1]); w.y = cvt_pk_bf16(a[2], a[3]); w.z = cvt_pk_bf16(b[0], b[1]); w.w = cvt_pk_bf16(b[2], b[3]);
                    *(u32x4*)(rowp + bj * 128) = w; } } } };

__device__ __forceinline__ void p6_mid(const Frame& F, const Args& A) {
    constexpr int PITCH = 4112;
    LAS unsigned char* tile = F.lds;
    LAS float* red = (LAS float*)(F.lds + 16 * PITCH);
    LAS int* lcnt = (LAS int*)(red + 8 * 16 * 32);
    LAS int* lbase = lcnt + 32;
    LAS int* tk_e = lbase + 32;
    LAS int* tk_ls = tk_e + 256;
    LAS float* PW = (LAS float*)(tk_ls + 256); LAS float* FW = PW + DM; LAS float* MODB = FW + DM;
    static_assert(16 * 4112 + 8 * 16 * 32 * 4 + (32 + 32 + 256 + 256) * 4 + 5 * DM * 4 <= RING_BYTES, "P6 LDS");
    const float* mod = (const float*)(F.ws + WS_MOD); const bf16_t* mix = (const bf16_t*)(F.ws + WS_MIX);
    bf16_t* x1p = (bf16_t*)(F.ws + WS_X1); unsigned char* h2p = F.ws + WS_H2;       const bf16_t* rwt = (const bf16_t*)(F.ws + WS_RWT);
    int* toke = (int*)(F.ws + WS_TOKE); float* tokg = (float*)(F.ws + WS_TOKG); int* toks = (int*)(F.ws + WS_TOKS); int* list = (int*)(F.ws + WS_LIST);
    const float* xin = ldp(F, I_X); const float* post_mix = ldp(F, I_POST_MIX); const float* pre_ffn = ldp(F, I_PRE_FFN);
    const int lane = F.lane, w = F.wave;
    if (F.tid < 32) lcnt[F.tid] = 0;
    { const f32x4 a = *(const f32x4*)(post_mix + 4 * F.tid), b = *(const f32x4*)(pre_ffn + 4 * F.tid); *(LAS f32x4*)(PW + 4 * F.tid) = a; *(LAS f32x4*)(FW + 4 * F.tid) = b; }
    __syncthreads();
    constexpr int NT = NTOK / 16;
    u32x2 mv[2][8]; f32x4 xv[2][8];
#define P6_LOAD(it_) do { _Pragma("unroll") for (int rr = 0; rr < 2; ++rr) { const size_t ro = (size_t)((it_) * 16 + 2 * w + rr) * DM + 4 * lane; \
        _Pragma("unroll") for (int j = 0; j < 8; ++j) { mv[rr][j] = *(const u32x2*)(mix + ro + 256 * j); xv[rr][j] = __builtin_nontemporal_load((const f32x4*)(xin + ro + 256 * j)); } } } while (0)
    const __amdgpu_buffer_rsrc_t rsm = __builtin_amdgcn_make_buffer_rsrc((void*)F.ws, 0, -1, 0x00020000);
#define P6_LOADM(it_) do { const unsigned _so = (unsigned)WS_MOD + (unsigned)(((it_) * 16) / SEQ) * (unsigned)(6 * DM * 4) + (unsigned)(2 * DM * 4) + (unsigned)w * 1024u; \
        _Pragma("unroll") for (int k = 0; k < 3; ++k) __builtin_amdgcn_raw_ptr_buffer_load_lds(rsm, (LAS void*)((LAS unsigned char*)MODB + k * (DM * 4) + w * 1024), 16, (unsigned)lane * 16u, _so + (unsigned)(k * DM * 4), 0, 0); } while (0)
    int it = F.bx, ti = 0;
    if (it < NT) { P6_LOADM(it); P6_LOAD(it); }
    for (; it < NT; it += F.G, ++ti) {
        const int r0 = it * 16;
        float r1[2], r2[2], ss2[2] = {0.f, 0.f};
#pragma unroll
        for (int rr = 0; rr < 2; ++rr) { float ss = 0.f;
#pragma unroll
            for (int j = 0; j < 8; ++j) { const float m0 = bf_lo(mv[rr][j].x), m1 = bf_hi(mv[rr][j].x), m2 = bf_lo(mv[rr][j].y), m3 = bf_hi(mv[rr][j].y); ss += m0 * m0 + m1 * m1 + m2 * m2 + m3 * m3; }
            r1[rr] = rsqrtf(wave_sum(ss) * (1.0f / DM) + EPS); }
        asm volatile("s_waitcnt vmcnt(0)" ::: "memory");
        __syncthreads();
#pragma unroll
        for (int j = 0; j < 8; ++j) { const int col = 4 * lane + 256 * j; const f32x4 pw = *(const LAS f32x4*)(PW + col), g1 = *(const LAS f32x4*)(MODB + col);
#pragma unroll
            for (int rr = 0; rr < 2; ++rr) { unsigned m0_ = mv[rr][j].x, m1_ = mv[rr][j].y; asm volatile("" : "+v"(m0_), "+v"(m1_));
                const float mm[4] = {bf_lo(m0_), bf_hi(m0_), bf_lo(m1_), bf_hi(m1_)};
#pragma unroll
                for (int i = 0; i < 4; ++i) { xv[rr][j][i] += g1[i] * (mm[i] * r1[rr] * pw[i]); ss2[rr] += xv[rr][j][i] * xv[rr][j][i]; }
                u32x2 xo; xo.x = cvt_pk_bf16(xv[rr][j][0], xv[rr][j][1]); xo.y = cvt_pk_bf16(xv[rr][j][2], xv[rr][j][3]);
                __builtin_nontemporal_store(xo, (u32x2*)(x1p + (size_t)(r0 + 2 * w + rr) * DM + col)); }
            asm volatile("" ::: "memory"); }
#pragma unroll
        for (int rr = 0; rr < 2; ++rr) r2[rr] = rsqrtf(wave_sum(ss2[rr]) * (1.0f / DM) + EPS);
#pragma unroll
        for (int j = 0; j < 8; ++j) { const int col = 4 * lane + 256 * j; const f32x4 fw = *(const LAS f32x4*)(FW + col), sh = *(const LAS f32x4*)(MODB + DM + col), sc = *(const LAS f32x4*)(MODB + 2 * DM + col);
#pragma unroll
            for (int rr = 0; rr < 2; ++rr) { const int rl = 2 * w + rr; float y[4];
#pragma unroll
                for (int i = 0; i < 4; ++i) y[i] = xv[rr][j][i] * r2[rr] * fw[i] * (1.0f + sc[i]) + sh[i];
                u32x2 o; o.x = cvt_pk_bf16(y[0], y[1]); o.y = cvt_pk_bf16(y[2], y[3]);
                *(unsigned*)(h2p + (size_t)(r0 + rl) * DM + col) = cvt4_fp8(y[0] * FP8_AS, y[1] * FP8_AS, y[2] * FP8_AS, y[3] * FP8_AS); *(LAS u32x2*)(tile + rl * PITCH + col * 2) = o; }
            asm volatile("" ::: "memory"); }
        __syncthreads();
        { f32x4 c0 = (f32x4){0.f, 0.f, 0.f, 0.f}, c1 = c0; bf16x8 b0[8], b1[8];
#pragma unroll
            for (int ks = 0; ks < 8; ++ks) { const int k0 = 256 * w + 32 * ks + 8 * (lane >> 4);
                b0[ks] = *(const bf16x8*)(rwt + (size_t)(lane & 15) * DM + k0); b1[ks] = *(const bf16x8*)(rwt + (size_t)(16 + (lane & 15)) * DM + k0); }
            asm volatile("" ::: "memory");
            if (it + F.G < NT) { P6_LOADM(it + F.G); P6_LOAD(it + F.G); }
            asm volatile("" ::: "memory");
#pragma unroll
            for (int ks = 0; ks < 8; ++ks) { const int k0 = 256 * w + 32 * ks + 8 * (lane >> 4);
                const bf16x8 a = *(const LAS bf16x8*)(tile + (lane & 15) * PITCH + k0 * 2);
                c0 = __builtin_amdgcn_mfma_f32_16x16x32_bf16(a, b0[ks], c0, 0, 0, 0); c1 = __builtin_amdgcn_mfma_f32_16x16x32_bf16(a, b1[ks], c1, 0, 0, 0); }
#pragma unroll
            for (int r = 0; r < 4; ++r) { red[(w * 16 + 4 * (lane >> 4) + r) * 32 + (lane & 15)] = c0[r]; red[(w * 16 + 4 * (lane >> 4) + r) * 32 + 16 + (lane & 15)] = c1[r]; } }
        __syncthreads();
        { const int rl = 2 * w + (lane >> 5), e = lane & 31, row = r0 + rl; float val = ldp(F, I_ROUTER_B)[e];
#pragma unroll
            for (int ww = 0; ww < 8; ++ww) val += red[(ww * 16 + rl) * 32 + e];
            float v[4]; int ix[4];
#pragma unroll
            for (int k = 0; k < 4; ++k) { float bv = val; int bi = e;
#pragma unroll
                for (int o = 1; o < 32; o <<= 1) { const float ov = __shfl_xor(bv, o); const int oi = __shfl_xor(bi, o); if (ov > bv || (ov == bv && oi < bi)) { bv = ov; bi = oi; } }
                v[k] = bv; ix[k] = bi; if (e == bi) val = -3.0e38f; }
            float gt[4], sum = 0.f;
#pragma unroll
            for (int k = 0; k < 4; ++k) { gt[k] = __expf(v[k] - v[0]); sum += gt[k]; }
            const float rs = 1.0f / sum;
#pragma unroll
            for (int k = 0; k < 4; ++k) if (e == ix[k]) { const int ls = atomicAdd((int*)&lcnt[e], 1); const int t = (ti * 16 + rl) * 4 + k;
                tk_e[t] = e; tk_ls[t] = ls; toke[row * 4 + k] = e; tokg[row * 4 + k] = gt[k] * rs; } }
    }
#undef P6_LOAD
#undef P6_LOADM
    __syncthreads();
    if (F.tid < 32) { const int n = lcnt[F.tid]; int base = 0; if (n > 0) base = (int)__hip_atomic_fetch_add(F.ctl + CW_CNT + 64 * F.tid, (unsigned)n, __ATOMIC_RELAXED, __HIP_MEMORY_SCOPE_AGENT); lbase[F.tid] = base; }
    __syncthreads();
    if (F.tid < ti * 64) { const int t = F.tid, tt = t >> 2, k = t & 3, e = tk_e[t], slot = lbase[e] + tk_ls[t], row = (F.bx + (tt >> 4) * F.G) * 16 + (tt & 15);
        toks[row * 4 + k] = slot; list[e * NTOK + slot] = row; }
    __syncthreads();
}

__device__ __forceinline__ int moe_tables(const Frame& F, int nN) {
    LAS int* toff = (LAS int*)(F.lds + MISC_OFF + 64); LAS int* cnt = (LAS int*)(F.lds + MISC_OFF + 256); LAS int* utab = (LAS int*)(F.lds + MISC_OFF + 512);
    __syncthreads();
    if (F.tid < 32) { int n = (int)__hip_atomic_load(F.ctl + CW_CNT + 64 * F.tid, __ATOMIC_RELAXED, __HIP_MEMORY_SCOPE_AGENT); n = n < 0 ? 0 : (n > NTOK ? NTOK : n); cnt[F.tid] = n; }
    __syncthreads();
    if (F.tid == 0) { int s = 0; for (int e = 0; e < 32; ++e) { toff[e] = s; s += (cnt[e] + 255) >> 8; } toff[32] = s; }
    __syncthreads();
    const int T = toff[32];
    if (F.tid < MAXU) { int v = -1; const int nwg = T * nN; const long L = (long)F.tid * F.G + F.bx;
        if (L < nwg) { int wgid = (int)L; { const int q = nwg / pg8::NXCD, r = nwg % pg8::NXCD, xcd = wgid % pg8::NXCD, off = wgid / pg8::NXCD; wgid = (xcd < r ? xcd * (q + 1) : r * (q + 1) + (xcd - r) * q) + off; }
            int e = 0; while (e < 31 && wgid >= toff[e + 1] * nN) ++e;
            const int loc = wgid - toff[e] * nN, ntl = toff[e + 1] - toff[e], pm = toff[e] + loc % ntl, pn = loc / ntl; v = pm | (pn << 12) | (e << 20); }
        utab[F.tid] = v; }
    __syncthreads();
    return T;
}
struct SchedMoe { unsigned a, bt; const LAS int* utab; const LAS int* toff; int nN; bool gather; int r0, nr;
    __device__ __forceinline__ bool next(int i_, pg8::Unit& u) const { const int i = r0 + i_; u.pm = 0; u.pn = 0; u.aux = 0; if (i_ >= nr || i >= MAXU) return false; const int v = __builtin_amdgcn_readfirstlane(utab[i]); if (v < 0) return false; u.pm = v & 4095; u.pn = (v >> 12) & 255; u.aux = v >> 20; return true; }
    __device__ __forceinline__ unsigned abase(const pg8::Unit& u) const { return gather ? a : a + (unsigned)u.pm * (256u * DM); }
    __device__ __forceinline__ unsigned bbase(const pg8::Unit& u) const { return bt + ((unsigned)u.aux * (unsigned)nN + (unsigned)u.pn) * (256u * DM); } };
struct EpiMoe1 { unsigned char* act; const float* b1;
    __device__ __forceinline__ void operator()(const f32x4 (&acc)[2][2][4][2], const pg8::Unit& u, int wr, int wc, int fr_, int fq_) const {
        const int ln_ = get_lane(); const int fr = ln_ & 15, fq = ln_ >> 4; (void)fr_; (void)fq_;
        const int row0 = u.pm * 256 + wr * 64 + fr, ch0 = 128 * u.pn + 32 * wc + 8 * fq; const float* bp = b1 + (size_t)u.aux * 2 * DFF + ch0;
        const f32x4 bg0 = *(const f32x4*)bp, bg1 = *(const f32x4*)(bp + 4), bl0 = *(const f32x4*)(bp + DFF), bl1 = *(const f32x4*)(bp + DFF + 4);
#pragma unroll
        for (int ai = 0; ai < 2; ++ai)
#pragma unroll
            for (int m = 0; m < 4; ++m) { const int row = row0 + ai * 128 + m * 16; float o[8];
#pragma unroll
                for (int n = 0; n < 2; ++n)
#pragma unroll
                    for (int ip = 0; ip < 2; ++ip) {
                        const f32x4 ag = acc[ai][0][m][n], al = acc[ai][1][m][n], bgv = n ? bg1 : bg0, blv = n ? bl1 : bl0;
                        const f32x2 a2 = {ag[2 * ip], ag[2 * ip + 1]}, l2 = {al[2 * ip], al[2 * ip + 1]}, bg2 = {bgv[2 * ip], bgv[2 * ip + 1]}, bl2 = {blv[2 * ip], blv[2 * ip + 1]};
                        f32x2 gl = a2 * FP8_DESCALE + bg2, li = l2 * FP8_DESCALE + bl2;
                        gl[0] = fminf(gl[0], 7.0f); gl[1] = fminf(gl[1], 7.0f); li[0] = fminf(fmaxf(li[0], -7.0f), 7.0f); li[1] = fminf(fmaxf(li[1], -7.0f), 7.0f);
                        const f32x2 xe = gl * (-1.702f * 1.4426950408889634f); f32x2 ee = {__builtin_amdgcn_exp2f(xe[0]), __builtin_amdgcn_exp2f(xe[1])}; ee = ee + 1.0f;
                        const f32x2 sg = {__builtin_amdgcn_rcpf(ee[0]), __builtin_amdgcn_rcpf(ee[1])};
                        const f32x2 ov = (gl * sg) * (li * FP8_AS + FP8_AS);
                        o[4 * n + 2 * ip] = ov[0]; o[4 * n + 2 * ip + 1] = ov[1]; }
                u32x2 w; w.x = cvt4_fp8(o[0], o[1], o[2], o[3]); w.y = cvt4_fp8(o[4], o[5], o[6], o[7]);
                *(u32x2*)(act + (unsigned)(row * DFF + ch0)) = w; } } };
constexpr float Y2_S = 32.0f;
struct EpiMoe2 { unsigned char* y2; const float* b2;
    __device__ __forceinline__ void operator()(const f32x4 (&acc)[2][2][4][2], const pg8::Unit& u, int wr, int wc, int fr_, int fq_) const {
        const int ln_ = get_lane(); const int fr = ln_ & 15, fq = ln_ >> 4; (void)fr_; (void)fq_;
        const int row0 = u.pm * 256 + wr * 64 + fr, col0 = 256 * u.pn + 32 * wc + 8 * fq; const float* bp = b2 + (size_t)u.aux * DM + col0;
        f32x4 bv[2][2];
#pragma unroll
        for (int bj = 0; bj < 2; ++bj) { bv[bj][0] = *(const f32x4*)(bp + 128 * bj) * Y2_S; bv[bj][1] = *(const f32x4*)(bp + 128 * bj + 4) * Y2_S; }
#pragma unroll
        for (int ai = 0; ai < 2; ++ai)
#pragma unroll
            for (int m = 0; m < 4; ++m) { const int row = row0 + ai * 128 + m * 16;
#pragma unroll
                for (int bj = 0; bj < 2; ++bj) { const f32x4 a = acc[ai][bj][m][0] * (FP8_DESCALE * Y2_S) + bv[bj][0], b = acc[ai][bj][m][1] * (FP8_DESCALE * Y2_S) + bv[bj][1];
                    u32x2 w; w.x = cvt4_fp8(a[0], a[1], a[2], a[3]); w.y = cvt4_fp8(b[0], b[1], b[2], b[3]);
                    *(u32x2*)(y2 + (unsigned)(row * DM + col0 + 128 * bj)) = w; } } } };

__device__ __forceinline__ void p9_final(const Frame& F, const Args& A) {
    LAS int* toff = (LAS int*)(F.lds + MISC_OFF + 64);
    (void)moe_tables(F, 8);
    const float* mod = (const float*)(F.ws + WS_MOD); const bf16_t* x1p = (const bf16_t*)(F.ws + WS_X1); const unsigned char* y2 = F.ws + WS_Y2;
    const int* toke = (const int*)(F.ws + WS_TOKE); const float* tokg = (const float*)(F.ws + WS_TOKG); const int* toks = (const int*)(F.ws + WS_TOKS);
    const int lane = F.lane;
    LAS float* PWL = (LAS float*)F.lds; LAS float* G2L = PWL + DM;
    static_assert((1 + NTOK / SEQ) * DM * 4 <= RING_BYTES && DM == 4 * 512, "P9 LDS");
    { *(LAS f32x4*)(PWL + 4 * F.tid) = *(const f32x4*)(ldp(F, I_POST_FFN) + 4 * F.tid);
#pragma unroll
      for (int bb = 0; bb < NTOK / SEQ; ++bb) *(LAS f32x4*)(G2L + bb * DM + 4 * F.tid) = *(const f32x4*)(mod + (size_t)bb * (6 * DM) + 5 * DM + 4 * F.tid); }
    __syncthreads();
    for (int row = F.bx * 8 + F.wave; row < NTOK; row += F.G * 8) {
        const float* mrow = mod + (size_t)(row / SEQ) * (6 * DM);
        f32x4 mo[8];
#pragma unroll
        for (int j = 0; j < 8; ++j) mo[j] = (f32x4){0.f, 0.f, 0.f, 0.f};
#pragma unroll
        for (int k = 0; k < 4; ++k) { const int e = toke[row * 4 + k]; const float gt = tokg[row * 4 + k]; const size_t r = (size_t)toff[e] * 256 + toks[row * 4 + k];
            const unsigned char* yp = y2 + r * DM + 4 * lane; const float gs = gt * (1.0f / Y2_S);
#pragma unroll
            for (int j = 0; j < 8; ++j) { const unsigned v = __builtin_nontemporal_load((const unsigned*)(yp + 256 * j));
                const auto lo = __builtin_amdgcn_cvt_pk_f32_fp8((int)v, false), hi = __builtin_amdgcn_cvt_pk_f32_fp8((int)v, true);
                mo[j][0] += gs * lo[0]; mo[j][1] += gs * lo[1]; mo[j][2] += gs * hi[0]; mo[j][3] += gs * hi[1]; } }
        float ss = 0.f;
#pragma unroll
        for (int j = 0; j < 8; ++j) ss += mo[j][0] * mo[j][0] + mo[j][1] * mo[j][1] + mo[j][2] * mo[j][2] + mo[j][3] * mo[j][3];
        const float rstd = rsqrtf(wave_sum(ss) * (1.0f / DM) + EPS);
#pragma unroll
        for (int j = 0; j < 8; ++j) { const int col = 4 * lane + 256 * j; const u32x2 xb = __builtin_nontemporal_load((const u32x2*)(x1p + (size_t)row * DM + col)); const f32x4 xv = (f32x4){bf_lo(xb.x), bf_hi(xb.x), bf_lo(xb.y), bf_hi(xb.y)}, pw = *(const LAS f32x4*)(PWL + col), g2 = *(const LAS f32x4*)(G2L + (row / SEQ) * DM + col);
            f32x4 o;
#pragma unroll
            for (int i = 0; i < 4; ++i) o[i] = xv[i] + g2[i] * (mo[j][i] * rstd * pw[i]);
            __builtin_nontemporal_store(o, (f32x4*)(ldp_out(F) + (size_t)row * DM + col)); }
    }
}

__global__ void __launch_bounds__(512, 2) fwd_kernel(Args args) {
    extern __shared__ __attribute__((aligned(16))) unsigned char lds_raw[];
    Frame F;
    F.lds = (LAS unsigned char*)lds_raw; F.wave = __builtin_amdgcn_readfirstlane((int)threadIdx.x >> 6); F.lane = get_lane(); F.tid = F.wave * 64 + F.lane; F.G = gridDim.x; F.bx = blockIdx.x;
    F.ws = args.ws; F.ctl = (unsigned*)(args.ws + WS_CTL);
    const Args& A = args;
    volatile LAS unsigned* MISC = (volatile LAS unsigned*)(F.lds + MISC_OFF);
    if (F.tid == 0) { LAS unsigned long long* pt = (LAS unsigned long long*)(F.lds + PTAB_OFF);
#pragma unroll
        for (int k = 0; k < 25; ++k) pt[k] = (unsigned long long)args.in[k];
        pt[25] = (unsigned long long)args.out; }
    if (F.tid < 4) MISC[F.tid] = 0u;
    __syncthreads();
#if N_LAUNCH_MODE == 1
    constexpr int lo = 0, hi = NPHASE; constexpr bool one = true;
#else
    const int lo = args.ph_lo, hi = args.ph_hi;
    const bool one = (hi - lo) > 1;
#endif
    XcdBarrier bar; bar.bar = F.ctl + CW_BAR; bar.x = 0; bar.st = MISC; bar.w0 = 0;
    if (one) bar = xcd_barrier_post(F.ctl + CW_BAR, MISC);
    bar.w0 = (F.wave == 0) ? 1 : 0;
#define IN(k) (lo <= (k) && (k) < hi)
#define REFRESH() do { F.lane = get_lane(); F.tid = F.wave * 64 + F.lane; } while (0)
#define SEAM(k) do { if (IN(k) && IN((k) + 1)) xcd_barrier(bar); } while (0)

    if (IN(0)) { REFRESH(); p0_prologue(F, A); } SEAM(0);
    if (IN(1)) { REFRESH(); p1_norm_mod(F, A); } SEAM(1);
    if (IN(2)) { REFRESH();
        const bool even = (F.G == 256);
        const int ntc = (F.bx < 64) ? 23 : 35, tb = (F.bx < 64) ? 23 * F.bx : 64 * 23 + (F.bx - 64) * 35;
        EpiIn E{F.ws};
        const int grp = (F.bx >> 3) & 3;
        EpiGlu8 E8{F.ws};
#pragma unroll 1
        for (int seg = 0; seg < 4; ++seg) {
            if (even && grp == seg) { REFRESH(); cvt_tiles_tp<true>(F, A, tb, 1, tb + ntc); REFRESH(); }
            if (seg == 2) { SchedIn S{F.G, F.bx, 0, 2, true}; pg8::gemm_phase<EpiGlu8, SchedIn, false, true, false>(F.lds, F.ws, F.wave, DM, S, E8, nullptr); }
            else { SchedIn S{F.G, F.bx, seg == 3 ? 4 : 2 * seg, seg == 3 ? (1 << 20) : 2, false}; pg8::gemm_phase<EpiIn, SchedIn, false, false>(F.lds, F.ws, F.wave, DM * 2, S, E, nullptr); }
        }
        if (!even) cvt_tiles<true>(F, A, F.bx, F.G, NE * 256 + NE * 128);
    } SEAM(2);
    if (IN(3)) { REFRESH(); for (int u = F.bx; u < 256; u += F.G) p3_state_unit(F, A, u); for (int u = F.bx; u < 256; u += F.G) p3_conv_unit(F, A, u); } SEAM(3);
    if (IN(4)) { REFRESH(); p4_retention(F, A); } SEAM(4);
    if (IN(5)) { REFRESH(); EpiBf16 E{(bf16_t*)(F.ws + WS_MIX), DM, FP8_DESCALE};
        SchedDense S{(unsigned)WS_Y, (unsigned)WS_WOUT, 64, 8, F.G, F.bx, (unsigned)DM, 0, 1 << 20}; pg8::gemm_phase<EpiBf16, SchedDense, false, true, false>(F.lds, F.ws, F.wave, DM, S, E, nullptr);
    } SEAM(5);
    if (IN(6)) { REFRESH(); p6_mid(F, A); } SEAM(6);
    if (IN(7)) { REFRESH();
        (void)moe_tables(F, 16);
        const LAS int* utab = (const LAS int*)(F.lds + MISC_OFF + 512); const LAS int* toff = (const LAS int*)(F.lds + MISC_OFF + 64); const LAS int* cnt = (const LAS int*)(F.lds + MISC_OFF + 256);
        LAS unsigned* gtab = (LAS unsigned*)(F.lds + GTAB_OFF); const int* list = (const int*)(F.ws + WS_LIST);
        for (int idx = F.tid; idx < MAXU * 256; idx += 512) { const int i = idx >> 8, r = idx & 255, v = utab[i]; unsigned off = 0u;
            if (v >= 0) { const int pm = v & 4095, e = v >> 20, slot = (pm - toff[e]) * 256 + r; const int tok = (slot < cnt[e]) ? list[e * NTOK + slot] : 0; off = (unsigned)tok * (unsigned)DM; }
            gtab[idx] = off; }
        __syncthreads();
        EpiMoe1 E{F.ws + WS_ACT, ldp(F, I_B1)};
        const bool even = (F.G == 256); const int tb = 8192 + 16 * F.bx;
        const int grp = (F.bx & 7) % 3;
        if (even && grp == 0) { cvt_tiles_tp<true>(F, A, tb, 1, tb + 16); REFRESH(); }
        { SchedMoe S{(unsigned)WS_H2, (unsigned)WS_W1, utab, toff, 16, true, 0, 9}; pg8::gemm_phase<EpiMoe1, SchedMoe, true, true, false>(F.lds, F.ws, F.wave, DM, S, E, gtab); }
        if (even && grp == 1) { REFRESH(); cvt_tiles_tp<true>(F, A, tb, 1, tb + 16); REFRESH(); }
        { SchedMoe S{(unsigned)WS_H2, (unsigned)WS_W1, utab, toff, 16, true, 9, 1 << 20}; pg8::gemm_phase<EpiMoe1, SchedMoe, true, true, false>(F.lds, F.ws, F.wave, DM, S, E, gtab + 9 * 256); }
        if (even && grp == 2) { REFRESH(); cvt_tiles_tp<true>(F, A, tb, 1, tb + 16); }
    } SEAM(7);
    if (IN(8)) { REFRESH();
        (void)moe_tables(F, 8);
        const LAS int* utab = (const LAS int*)(F.lds + MISC_OFF + 512); const LAS int* toff = (const LAS int*)(F.lds + MISC_OFF + 64);
        SchedMoe S{(unsigned)WS_ACT, (unsigned)WS_W2, utab, toff, 8, false, 0, 1 << 20}; EpiMoe2 E{F.ws + WS_Y2, ldp(F, I_B2)};
        pg8::gemm_phase<EpiMoe2, SchedMoe, false, true, false>(F.lds, F.ws, F.wave, DFF, S, E, nullptr); } SEAM(8);
    if (IN(9)) { REFRESH(); p9_final(F, A); }
#undef IN
#undef SEAM
}

extern "C" void kernel_launch(void* const* d_in, const int* in_sizes, int n_in, void* d_out, int out_size, void* d_ws, size_t ws_size, hipStream_t stream) {
    static int grid = 0;
    if (grid == 0) {
        if (n_in != 25 || ws_size < WS_END) { fprintf(stderr, "kernel_launch: unexpected n_in %d or workspace %zu < %zu\n", n_in, ws_size, (size_t)WS_END); grid = -1; return; }
        int dev = 0, cus = 0, per_cu = 0;
        if (hipGetDevice(&dev) != hipSuccess || hipDeviceGetAttribute(&cus, hipDeviceAttributeMultiprocessorCount, dev) != hipSuccess) { grid = -1; return; }
        if (hipFuncSetAttribute((const void*)fwd_kernel, hipFuncAttributeMaxDynamicSharedMemorySize, LDS_BYTES) != hipSuccess) { fprintf(stderr, "kernel_launch: hipFuncSetAttribute failed\n"); grid = -1; return; }
        if (hipOccupancyMaxActiveBlocksPerMultiprocessor(&per_cu, (const void*)fwd_kernel, 512, LDS_BYTES) != hipSuccess || per_cu < 1) { fprintf(stderr, "kernel_launch: occupancy query says %d\n", per_cu); }
        (void)hipGetLastError();
        grid = cus;
    }
    if (grid < 0) return;
    (void)hipMemsetAsync((char*)d_ws + WS_CTL, 0, CTL_ZERO_BYTES, stream);
    Args a{};
    for (int i = 0; i < 25; ++i) a.in[i] = (const float*)d_in[i];
    a.out = (float*)d_out; a.ws = (unsigned char*)d_ws;
#if N_LAUNCH_MODE == 1
    a.ph_lo = 0; a.ph_hi = NPHASE;
    hipLaunchKernelGGL(fwd_kernel, dim3(grid), dim3(512), LDS_BYTES, stream, a);
#else
    for (int p = 0; p < NPHASE; ++p) { a.ph_lo = p; a.ph_hi = p + 1; hipLaunchKernelGGL(fwd_kernel, dim3(grid), dim3(512), LDS_BYTES, stream, a); }
#endif
}
```

```cpp
#include <hip/hip_runtime.h>
#include <cstdio>
#include <cstdint>

#ifndef N_LAUNCH_MODE
#define N_LAUNCH_MODE 1
#endif

#define LAS __attribute__((address_space(3)))
typedef unsigned short bf16_t;
typedef short bf16x8 __attribute__((ext_vector_type(8)));
typedef short s16x4 __attribute__((ext_vector_type(4)));
typedef float f32x4 __attribute__((ext_vector_type(4)));
typedef float f32x2 __attribute__((ext_vector_type(2)));
typedef unsigned u32x4 __attribute__((ext_vector_type(4)));
typedef unsigned u32x2 __attribute__((ext_vector_type(2)));
typedef int i32x4 __attribute__((ext_vector_type(4)));
typedef int i32x8 __attribute__((ext_vector_type(8)));
typedef int i32x16 __attribute__((ext_vector_type(16)));
typedef int i32x32 __attribute__((ext_vector_type(32)));

constexpr int NB = 8, SEQ = 2048, DM = 2048, NTOK = NB * SEQ, CTXL = 256, NCTX = NB * CTXL;
constexpr int NH = 8, HD = 128, DRET = 1024, DCONV = 1024, DIN = 6144, CONVW = 31, CONVP = 15, CHUNK = 128, NCHUNK = SEQ / CHUNK;
constexpr int NE = 32, TOPK = 4, DFF = 2048, GRIDW = 64;
constexpr float EPS = 1e-6f, GN_EPS = 1e-5f;
constexpr int MAXTILES = NTOK * TOPK / 256 + NE;
constexpr int NPHASE = 10;

constexpr size_t MiB = 1u << 20;
constexpr size_t WS_CTL = 0, CTL_ZERO_BYTES = 65536;
constexpr size_t WS_MOD = 1 * MiB;
constexpr size_t WS_RWT = 2 * MiB;
constexpr size_t WS_WIN = 4 * MiB;
constexpr size_t WS_WOUT = 28 * MiB;
constexpr size_t WS_W1 = 36 * MiB;
constexpr size_t WS_W2 = 548 * MiB;
constexpr size_t WS_HLAT = 804 * MiB;
constexpr size_t WS_HCTX = 868 * MiB;
constexpr size_t WS_Q = 876 * MiB, WS_K = 908 * MiB, WS_V = 940 * MiB, WS_G = 972 * MiB, WS_U = 1004 * MiB;
constexpr size_t WS_KC = 1036 * MiB, WS_VC = 1040 * MiB;
constexpr size_t WS_SF = 1044 * MiB, WS_SB = 1076 * MiB;
constexpr size_t WS_Y = 1108 * MiB;
constexpr size_t WS_MIX = 1172 * MiB;
constexpr size_t WS_X1 = 1300 * MiB;
constexpr size_t WS_H2 = 1428 * MiB;
constexpr size_t WS_TOKE = 1492 * MiB, WS_TOKG = 1493 * MiB, WS_TOKS = 1494 * MiB;
constexpr size_t WS_LIST = 1495 * MiB;
constexpr size_t WS_ACT = 1497 * MiB;
constexpr size_t WS_Y2 = 1785 * MiB;
constexpr size_t WS_H8 = 2073 * MiB;
constexpr size_t WS_WIN8 = 2105 * MiB;
constexpr size_t WS_END = 2109 * MiB;
constexpr int CW_TMO = 0, CW_BAR = 4096, CW_CNT = 8192;

constexpr int RING_BYTES = 139264;
constexpr int MISC_OFF = RING_BYTES;
constexpr int PTAB_OFF = MISC_OFF + 640;
constexpr int GTAB_OFF = MISC_OFF + 1024;
constexpr int MAXU = 20;
constexpr int LDS_BYTES = GTAB_OFF + MAXU * 1024;
static_assert(LDS_BYTES <= 163840, "LDS");

__device__ __forceinline__ unsigned cvt_pk_bf16(float lo, float hi) { unsigned r; asm("v_cvt_pk_bf16_f32 %0, %1, %2" : "=v"(r) : "v"(lo), "v"(hi)); return r; }
__device__ __forceinline__ float bf_lo(unsigned u) { return __uint_as_float(u << 16); }
__device__ __forceinline__ float bf_hi(unsigned u) { return __uint_as_float(u & 0xffff0000u); }
__device__ __forceinline__ float bf1(bf16_t b) { return __uint_as_float(((unsigned)b) << 16); }
__device__ __forceinline__ float wave_sum(float v) {
#pragma unroll
    for (int o = 32; o >= 1; o >>= 1) v += __shfl_xor(v, o);
    return v; }
__device__ __forceinline__ float sigmoidf_(float x) { return __builtin_amdgcn_rcpf(1.0f + __expf(-x)); }
__device__ __forceinline__ float siluf_(float x) { return x * sigmoidf_(x); }
__device__ __forceinline__ float log_sigmoid_(float x) { return fminf(x, 0.f) - log1pf(__expf(-fabsf(x))); }
constexpr float FP8_AS = 4.0f, FP8_BS = 64.0f, FP8_DESCALE = 1.0f / (FP8_AS * FP8_BS);
__device__ __forceinline__ unsigned cvt4_fp8(float a, float b, float c, float d) { int p = __builtin_amdgcn_cvt_pk_fp8_f32(a, b, 0, false); p = __builtin_amdgcn_cvt_pk_fp8_f32(c, d, p, true); return (unsigned)p; }
__device__ __forceinline__ int get_lane() { int l; asm volatile("v_mbcnt_lo_u32_b32 %0, -1, 0\n\tv_mbcnt_hi_u32_b32 %0, -1, %0" : "=v"(l)); return l; }
__host__ __device__ __forceinline__ int slot128(int r) { return 32 * (r >> 5) + 16 * ((r >> 2) & 1) + 4 * ((r >> 3) & 3) + (r & 3); }

#define XB_TMO      128
#define XB_XCNT(j)  (256  + 64 * (j))
#define XB_XSUB(j)  (1280 + 64 * (j))
#define XB_XGEN(j)  (2304 + 64 * (j))
#define XB_TOP      3328
#define XB_TOPGEN   3392
#define XCD_BAR_WORDS 3456
#define XB_SPIN_CAP (1u << 18)

__device__ __forceinline__ unsigned xb_ld(unsigned* p)              { return __hip_atomic_load(p, __ATOMIC_RELAXED, __HIP_MEMORY_SCOPE_AGENT); }
__device__ __forceinline__ unsigned xb_add(unsigned* p, unsigned v) { return __hip_atomic_fetch_add(p, v, __ATOMIC_RELAXED, __HIP_MEMORY_SCOPE_AGENT); }
__device__ __forceinline__ unsigned xb_xcc_id() { return (unsigned)__builtin_amdgcn_s_getreg((3 << 11) | 20) & 0xFu; }
#define XB_SPIN(cond, bar) do { unsigned _sp = 0; while (cond) { __builtin_amdgcn_s_sleep(1); \
    if ((++_sp & 255u) == 0u) { if (xb_ld(&(bar)[XB_TMO])) break; if (_sp > XB_SPIN_CAP) { atomicAdd(&(bar)[XB_TMO], 1u); break; } } } } while (0)

struct XcdBarrier { unsigned* bar; unsigned x; volatile LAS unsigned* st; int w0; };

__device__ __forceinline__ XcdBarrier xcd_barrier_post(unsigned* bar, volatile LAS unsigned* st) {
    XcdBarrier b; b.bar = bar; b.x = xb_xcc_id(); b.st = st; b.w0 = 0;
    if (threadIdx.x == 0) (void)xb_add(&bar[XB_XCNT(b.x)], 1u);
    return b;
}
__device__ __forceinline__ void xcd_barrier_complete(unsigned* bar, unsigned x, unsigned& nloc, unsigned& nx) {
    const unsigned G = gridDim.x * gridDim.y * gridDim.z;
    unsigned sum, cnt, mine, sp = 0u;
    for (;;) {
        sum = 0u; cnt = 0u; mine = 0u;
#pragma unroll
        for (unsigned j = 0; j < 16; ++j) { const unsigned c = xb_ld(&bar[XB_XCNT(j)]); sum += c; cnt += (c > 0u) ? 1u : 0u; mine = (j == x) ? c : mine; }
        if (sum == G) break;
        __builtin_amdgcn_s_sleep(1);
        if ((++sp & 255u) == 0u) { if (xb_ld(&bar[XB_TMO])) break; if (sp > XB_SPIN_CAP) { atomicAdd(&bar[XB_TMO], 1u); break; } }
    }
    nloc = mine > 0u ? mine : 1u; nx = cnt > 0u ? cnt : 1u;
}
__device__ __forceinline__ void xcd_barrier(const XcdBarrier& b) {
    asm volatile("s_waitcnt vmcnt(0)" ::: "memory");
    __syncthreads();
    if (b.w0 && get_lane() == 0) {
        unsigned* bar = b.bar;
        __builtin_amdgcn_s_waitcnt(0);
        unsigned nloc = b.st[0], nx = b.st[1];
        if (nloc == 0u) { xcd_barrier_complete(bar, b.x, nloc, nx); b.st[0] = nloc; b.st[1] = nx; }
        const unsigned old = xb_add(&bar[XB_XSUB(b.x)], 1u);
        const unsigned gen = old / nloc;
        if (old + 1u == (gen + 1u) * nloc) {
            __builtin_amdgcn_fence(__ATOMIC_RELEASE, "agent");
            asm volatile("s_waitcnt vmcnt(0)" ::: "memory");
            const unsigned og = xb_add(&bar[XB_TOP], 1u);
            const unsigned tg = og / nx;
            if (og + 1u == (tg + 1u) * nx) xb_add(&bar[XB_TOPGEN], 1u);
            else XB_SPIN(xb_ld(&bar[XB_TOPGEN]) == tg, bar);
            __builtin_amdgcn_fence(__ATOMIC_ACQUIRE, "agent");
            xb_add(&bar[XB_XGEN(b.x)], 1u);
            asm volatile("s_waitcnt vmcnt(0)" ::: "memory");
        } else {
            XB_SPIN(xb_ld(&bar[XB_XGEN(b.x)]) == gen, bar);
            __builtin_amdgcn_fence(__ATOMIC_ACQUIRE, "agent");
            asm volatile("s_waitcnt vmcnt(0)" ::: "memory");
        }
    }
    __syncthreads();
}

namespace pg8 {
constexpr int BM = 256, BK = 64, HALF = 128, HTB = HALF * BK * 2, STAGE_BYTES = 8 * HTB, NXCD = 8, WGM = 8;
__host__ __device__ __forceinline__ int lds_byte(int r, int c) { const int st = (r >> 4) * 2 + (c >> 5), rr = r & 15, cc = c & 31, ob = rr * 64 + cc * 2; return st * 1024 + (ob ^ (((ob >> 9) & 1) << 5)); }
__host__ __device__ __forceinline__ void stage_rc(int b, int& R, int& C) { const int st = b / 1024, sb = b % 1024, swz = sb ^ (((sb >> 9) & 1) << 5); R = (st >> 1) * 16 + swz / 64; C = (st & 1) * 32 + (swz % 64) / 2; }

struct Unit { int pm, pn, aux; };
__device__ __forceinline__ unsigned vadd_opaque(unsigned a, unsigned k) { unsigned r; asm volatile("v_add_u32 %0, %1, %2" : "=v"(r) : "v"(a), "s"(k)); return r; }
__device__ __forceinline__ i32x8 cat8(bf16x8 lo, bf16x8 hi) { const i32x4 a = (i32x4)lo, b = (i32x4)hi; return __builtin_shufflevector(a, b, 0, 1, 2, 3, 4, 5, 6, 7); }
__device__ __forceinline__ bf16x8 lo8(i32x8 v) { return (bf16x8)__builtin_shufflevector(v, v, 0, 1, 2, 3); }
__device__ __forceinline__ bf16x8 hi8(i32x8 v) { return (bf16x8)__builtin_shufflevector(v, v, 4, 5, 6, 7); }
__device__ __forceinline__ bool static_order(int nM, int nN, int G, int c, int i, int& pm, int& pn) {
    const int nwg = nM * nN; const long L = (long)i * G + c; if (L >= nwg) return false;
    int wgid = (int)L; { const int q = nwg / NXCD, r = nwg % NXCD, xcd = wgid % NXCD, off = wgid / NXCD; wgid = (xcd < r ? xcd * (q + 1) : r * (q + 1) + (xcd - r) * q) + off; }
    const int nig = WGM * nN, gid = wgid / nig, fm = gid * WGM, gsz = (nM - fm) < WGM ? (nM - fm) : WGM;
    pm = fm + ((wgid % nig) % gsz); pn = (wgid % nig) / gsz; return true;
}

template <class Epi, class Sched, bool GATHER, bool FP8, bool SPLIT = FP8>
__device__ __forceinline__ void gemm_phase(LAS unsigned char* lds, unsigned char* wsbase, const int wid, const int RB, const Sched& S, const Epi& E, const LAS unsigned* gtab) {
    const int lane = get_lane(), tid = wid * 64 + lane, wr = wid >> 2, wc = wid & 3, fr = lane & 15, fq = lane >> 4;
    const int nt = RB / 128;
    const __amdgpu_buffer_rsrc_t rs = __builtin_amdgcn_make_buffer_rsrc((void*)wsbase, 0, -1, 0x00020000);
    unsigned voff0; int rowA0;
    { int R, C; stage_rc(tid * 16, R, C); voff0 = (unsigned)(R * RB + C * 2); rowA0 = R; }
#define PG8_VOFF(i_) ((i_) == 0 ? voff0 : vadd_opaque(voff0, 64u * (unsigned)RB))
#define PG8_ROWA(i_) ((i_) == 0 ? rowA0 : (int)vadd_opaque((unsigned)rowA0, 64u))
    const unsigned kstep = 128u;
    const unsigned hstep = (unsigned)HALF * (unsigned)RB;
    const unsigned ahstep = GATHER ? 0u : hstep;
    const unsigned ldsw = (unsigned)wid * 1024u;
    const int aoff = lds_byte(wr * 64 + fr, fq * 8), boff = lds_byte(wc * 32 + fr, fq * 8);
#define PG8_SA(b, h) (((b) * 2 + (h)) * HTB)
#define PG8_SB(b, h) ((4 + (b) * 2 + (h)) * HTB)
#define PG8_STAGE_B(bufoff, soff) do { _Pragma("unroll") for (int _i = 0; _i < 2; ++_i) \
        __builtin_amdgcn_raw_ptr_buffer_load_lds(rs, (LAS void*)(lds + (bufoff) + ldsw + _i * 8192), 16, PG8_VOFF(_i), (soff), 0, 0); } while (0)
#define PG8_GOFF(h, uidx) do { if constexpr (GATHER) { _Pragma("unroll") for (int _i = 0; _i < 2; ++_i) go[_i] = gtab[(uidx) * 256 + (h) * 128 + PG8_ROWA(_i)] + (voff0 - (unsigned)(rowA0 * RB)); } } while (0)
#define PG8_STAGE_A(bufoff, soff, h) do { _Pragma("unroll") for (int _i = 0; _i < 2; ++_i) \
        __builtin_amdgcn_raw_ptr_buffer_load_lds(rs, (LAS void*)(lds + (bufoff) + ldsw + _i * 8192), 16, GATHER ? go[_i] : PG8_VOFF(_i), (soff) + (unsigned)(h) * ahstep, 0, 0); } while (0)
#define PG8_LD8(addr) cat8(*(const LAS bf16x8*)(addr), *(const LAS bf16x8*)((addr) + 1024))
#define PG8_LDA(dst, b, h) do { _Pragma("unroll") for (int m = 0; m < 4; ++m) dst[m] = PG8_LD8(lds + PG8_SA(b, h) + aoff + m * 2048); } while (0)
#define PG8_LDA2(dst, b, h, m0) do { _Pragma("unroll") for (int m = 0; m < 2; ++m) dst[m] = PG8_LD8(lds + PG8_SA(b, h) + aoff + ((m0) + m) * 2048); } while (0)
#define PG8_LDB(dst, b, h) do { _Pragma("unroll") for (int n = 0; n < 2; ++n) dst[n] = PG8_LD8(lds + PG8_SB(b, h) + boff + n * 2048); } while (0)
#define PG8_MMA(ai, bj, At, Bt) do { __builtin_amdgcn_s_setprio(1); _Pragma("unroll") for (int m = 0; m < 4; ++m) _Pragma("unroll") for (int n = 0; n < 2; ++n) { \
        if constexpr (FP8) { acc[ai][bj][m][n] = __builtin_amdgcn_mfma_scale_f32_16x16x128_f8f6f4(Bt[n], At[m], acc[ai][bj][m][n], 0, 0, 0, 0x7F7F7F7F, 0, 0x7F7F7F7F); } \
        else { acc[ai][bj][m][n] = __builtin_amdgcn_mfma_f32_16x16x32_bf16(lo8(Bt[n]), lo8(At[m]), acc[ai][bj][m][n], 0, 0, 0); \
               acc[ai][bj][m][n] = __builtin_amdgcn_mfma_f32_16x16x32_bf16(hi8(Bt[n]), hi8(At[m]), acc[ai][bj][m][n], 0, 0, 0); } } \
        __builtin_amdgcn_s_setprio(0); } while (0)
#define PG8_MMA2(ai, At, m0) do { __builtin_amdgcn_s_setprio(1); _Pragma("unroll") for (int m = 0; m < 2; ++m) _Pragma("unroll") for (int n = 0; n < 2; ++n) { \
        acc[ai][0][(m0) + m][n] = __builtin_amdgcn_mfma_scale_f32_16x16x128_f8f6f4(B0[n], At[m], acc[ai][0][(m0) + m][n], 0, 0, 0, 0x7F7F7F7F, 0, 0x7F7F7F7F); \
        acc[ai][1][(m0) + m][n] = __builtin_amdgcn_mfma_scale_f32_16x16x128_f8f6f4(B1[n], At[m], acc[ai][1][(m0) + m][n], 0, 0, 0, 0x7F7F7F7F, 0, 0x7F7F7F7F); } \
        __builtin_amdgcn_s_setprio(0); } while (0)
#define PG8_WAIT_V(n) asm volatile("s_waitcnt vmcnt(" #n ")" ::: "memory")
#define PG8_WAIT_L(n) asm volatile("s_waitcnt lgkmcnt(" #n ")" ::: "memory")
#define PG8_BAR __builtin_amdgcn_s_barrier()
#define PG8_SCHED __builtin_amdgcn_sched_barrier(0)
    Unit cur, nxt; int ui = 0;
    if (!S.next(0, cur)) return;
    f32x4 acc[2][2][4][2];
#pragma unroll
    for (int a = 0; a < 2; ++a)
#pragma unroll
        for (int b = 0; b < 2; ++b)
#pragma unroll
            for (int m = 0; m < 4; ++m)
#pragma unroll
                for (int n = 0; n < 2; ++n) acc[a][b][m][n] = (f32x4){0.f, 0.f, 0.f, 0.f};
    i32x8 At[SPLIT ? 2 : 4], B0[2], B1[2];
    unsigned cA = S.abase(cur), cB = S.bbase(cur);
    unsigned go[2] = {0u, 0u};
    PG8_STAGE_B(PG8_SB(0, 0), cB); PG8_STAGE_B(PG8_SB(0, 1), cB + hstep); PG8_GOFF(0, 0); PG8_STAGE_A(PG8_SA(0, 0), cA, 0); PG8_GOFF(1, 0); PG8_STAGE_A(PG8_SA(0, 1), cA, 1);
    if (wr == 1) PG8_BAR;
    PG8_WAIT_V(2); PG8_BAR;
    PG8_STAGE_B(PG8_SB(1, 0), cB + kstep); PG8_GOFF(0, 0); PG8_STAGE_A(PG8_SA(1, 0), cA + kstep, 0); PG8_STAGE_B(PG8_SB(1, 1), cB + hstep + kstep);
    PG8_WAIT_V(6); PG8_BAR;
    for (;;) {
        const bool has_next = S.next(ui + 1, nxt);
        const unsigned nA = has_next ? S.abase(nxt) : cA, nB = has_next ? S.bbase(nxt) : cB;
        for (int t = 0; t < nt; t += 2) {
            const bool last = (t == nt - 2);
            const bool nx = last && has_next;
            const unsigned a1 = cA + (unsigned)(t + 1) * kstep;
            const unsigned a2 = last ? nA : cA + (unsigned)(t + 2) * kstep, b2 = last ? nB : cB + (unsigned)(t + 2) * kstep;
            const unsigned a3 = a2 + kstep, b3 = b2 + kstep;
            const int un = nx ? ui + 1 : ui;
            if constexpr (!SPLIT) {
            PG8_GOFF(1, ui); PG8_LDB(B0, 0, 0); PG8_LDB(B1, 0, 1); PG8_SCHED; PG8_LDA(At, 0, 0); PG8_STAGE_A(PG8_SA(1, 1), a1, 1);
            PG8_WAIT_V(8); PG8_WAIT_L(0); PG8_BAR; PG8_MMA(0, 0, At, B0); PG8_MMA(0, 1, At, B1); PG8_BAR; PG8_SCHED;
            PG8_GOFF(0, un); PG8_LDA(At, 0, 1); PG8_STAGE_B(PG8_SB(0, 0), b2); PG8_STAGE_B(PG8_SB(0, 1), b2 + hstep); PG8_STAGE_A(PG8_SA(0, 0), a2, 0);
            PG8_WAIT_V(8); PG8_WAIT_L(0); PG8_BAR; PG8_MMA(1, 0, At, B0); PG8_MMA(1, 1, At, B1); PG8_BAR; PG8_SCHED;
            PG8_GOFF(1, un); PG8_LDB(B0, 1, 0); PG8_LDB(B1, 1, 1); PG8_SCHED; PG8_LDA(At, 1, 0); PG8_STAGE_A(PG8_SA(0, 1), a2, 1);
            PG8_WAIT_V(8); PG8_WAIT_L(0); PG8_BAR; PG8_MMA(0, 0, At, B0); PG8_MMA(0, 1, At, B1); PG8_BAR; PG8_SCHED;
            PG8_GOFF(0, un); PG8_LDA(At, 1, 1); PG8_STAGE_B(PG8_SB(1, 0), b3); PG8_STAGE_B(PG8_SB(1, 1), b3 + hstep); PG8_STAGE_A(PG8_SA(1, 0), a3, 0);
            PG8_WAIT_V(8); PG8_WAIT_L(0); PG8_BAR; PG8_MMA(1, 0, At, B0); PG8_MMA(1, 1, At, B1); PG8_BAR; PG8_SCHED;
            } else {
            PG8_GOFF(1, ui); PG8_LDB(B0, 0, 0); PG8_LDB(B1, 0, 1); PG8_SCHED; PG8_LDA2(At, 0, 0, 0); PG8_STAGE_A(PG8_SA(1, 1), a1, 1);
            PG8_WAIT_V(8); PG8_WAIT_L(0); PG8_BAR; PG8_MMA2(0, At, 0); PG8_BAR; PG8_SCHED;
            PG8_LDA2(At, 0, 0, 2); PG8_WAIT_L(0); PG8_BAR; PG8_MMA2(0, At, 2); PG8_BAR; PG8_SCHED;
            PG8_GOFF(0, un); PG8_LDA2(At, 0, 1, 0); PG8_STAGE_B(PG8_SB(0, 0), b2); PG8_STAGE_B(PG8_SB(0, 1), b2 + hstep); PG8_STAGE_A(PG8_SA(0, 0), a2, 0);
            PG8_WAIT_V(8); PG8_WAIT_L(0); PG8_BAR; PG8_MMA2(1, At, 0); PG8_BAR; PG8_SCHED;
            PG8_LDA2(At, 0, 1, 2); PG8_WAIT_L(0); PG8_BAR; PG8_MMA2(1, At, 2); PG8_BAR; PG8_SCHED;
            PG8_GOFF(1, un); PG8_LDB(B0, 1, 0); PG8_LDB(B1, 1, 1); PG8_SCHED; PG8_LDA2(At, 1, 0, 0); PG8_STAGE_A(PG8_SA(0, 1), a2, 1);
            PG8_WAIT_V(8); PG8_WAIT_L(0); PG8_BAR; PG8_MMA2(0, At, 0); PG8_BAR; PG8_SCHED;
            PG8_LDA2(At, 1, 0, 2); PG8_WAIT_L(0); PG8_BAR; PG8_MMA2(0, At, 2); PG8_BAR; PG8_SCHED;
            PG8_GOFF(0, un); PG8_LDA2(At, 1, 1, 0); PG8_STAGE_B(PG8_SB(1, 0), b3); PG8_STAGE_B(PG8_SB(1, 1), b3 + hstep); PG8_STAGE_A(PG8_SA(1, 0), a3, 0);
            PG8_WAIT_V(8); PG8_WAIT_L(0); PG8_BAR; PG8_MMA2(1, At, 0); PG8_BAR; PG8_SCHED;
            PG8_LDA2(At, 1, 1, 2); PG8_WAIT_L(0); PG8_BAR; PG8_MMA2(1, At, 2); PG8_BAR; PG8_SCHED;
            }
        }
        if (wr == 0) PG8_BAR;
        E(acc, cur, wr, wc, fr, fq);
        if (!has_next) break;
#pragma unroll
        for (int a = 0; a < 2; ++a)
#pragma unroll
            for (int b = 0; b < 2; ++b)
#pragma unroll
                for (int m = 0; m < 4; ++m)
#pragma unroll
                    for (int n = 0; n < 2; ++n) acc[a][b][m][n] = (f32x4){0.f, 0.f, 0.f, 0.f};
        cur = nxt; cA = nA; cB = nB; ++ui;
        if (wr == 1) PG8_BAR;
    }
    PG8_WAIT_V(0);
    PG8_BAR;
#undef PG8_SA
#undef PG8_SB
#undef PG8_STAGE_A
#undef PG8_STAGE_B
#undef PG8_LDA
#undef PG8_LD8
#undef PG8_LDA2
#undef PG8_MMA2
#undef PG8_LDB
#undef PG8_MMA
#undef PG8_WAIT_V
#undef PG8_WAIT_L
#undef PG8_BAR
#undef PG8_SCHED
#undef PG8_GOFF
#undef PG8_VOFF
#undef PG8_ROWA
}
}

struct Args { const float* in[25]; float* out; unsigned char* ws; int ph_lo, ph_hi; };
struct Frame {
    LAS unsigned char* lds; int tid, lane, wave, G, bx;
    unsigned char* ws; unsigned* ctl;
};
enum { I_X = 0, I_C, I_CTX, I_C_CTX, I_ADA_W, I_ADA_B, I_PRE_MIX, I_POST_MIX, I_PRE_FFN, I_POST_FFN, I_W_IN, I_DEC_F, I_DEC_B, I_GN_W, I_CONV_W, I_CONV_B, I_LN_W, I_LN_B, I_W_OUT,
       I_ROUTER_W, I_ROUTER_B, I_W1, I_B1, I_W2, I_B2, I_OUT };
__device__ __forceinline__ const float* ldp(const Frame& F, int k) {
    const unsigned long long v = *(const LAS unsigned long long*)(F.lds + PTAB_OFF + 8 * k);
    const unsigned lo = __builtin_amdgcn_readfirstlane((unsigned)v), hi = __builtin_amdgcn_readfirstlane((unsigned)(v >> 32));
    return (const float*)(const __attribute__((address_space(1))) float*)(((unsigned long long)hi << 32) | lo); }
__device__ __forceinline__ float* ldp_out(const Frame& F) { return (float*)ldp(F, I_OUT); }

__device__ __forceinline__ int dest_row(int kind, int n) {
    if (kind == 0) return n;
    if (kind == 3) return (n & ~127) + slot128(n & 127);
    if (kind == 4) { const int c = n - 4096, ch = c & 1023, second = c >> 10; return 256 * (ch >> 7) + 128 * second + slot128(ch & 127); }
    if (kind == 2) { const int ch = n & 2047, second = n >> 11; return 256 * (ch >> 7) + 128 * second + slot128(ch & 127); }
    if (n < 2048) { const int base = n & ~1023, c = n & 1023, head = c >> 7, j = c & 127, pnl = head >> 1, bj = head & 1, nn = j >> 6, jj = j & 63;
        return base + 256 * pnl + 128 * bj + 32 * (jj >> 4) + 16 * nn + 4 * ((jj >> 2) & 3) + (jj & 3); }
    if (n < 4096) return (n & ~127) + slot128(n & 127);
    { const int c = n - 4096, ch = c & 1023, second = c >> 10; return 4096 + 256 * (ch >> 7) + 128 * second + slot128(ch & 127); }
}
struct CvtTile { const float* src; unsigned char* dst; int ldn, rowbytes, k0, n0, kind; };
template <bool FP8> __device__ __forceinline__ CvtTile cvt_decode(const Frame& F, const Args& A, int t) {
    CvtTile c;
    if constexpr (!FP8) {
        if (t < 32 * 16) { const int kt = t / 16, ntl = t % 16;                                  c.src = ldp(F, I_W_IN); c.dst = F.ws + WS_WIN; c.ldn = DIN; c.rowbytes = DM * 2; c.k0 = kt * 64; c.n0 = ntl * 256; c.kind = 1; }
        else { const int q = t - 32 * 16, kt = q / 8, ntl = q % 8; c.src = ldp(F, I_W_OUT); c.dst = F.ws + WS_WOUT; c.ldn = DM; c.rowbytes = DM * 2; c.k0 = kt * 64; c.n0 = ntl * 256; c.kind = 3; }
    } else {
        if (t < NE * 256) { const int e = t >> 8, r = t & 255, ntl = r >> 4, kt = r & 15;       c.src = ldp(F, I_W1) + (size_t)e * DM * 2 * DFF; c.dst = F.ws + WS_W1 + (size_t)e * 2 * DFF * DM; c.ldn = 2 * DFF; c.rowbytes = DM; c.k0 = kt * 128; c.n0 = ntl * 256; c.kind = 2; }
        else if (t < NE * 256 + NE * 128) { const int q = t - NE * 256, e = q >> 7, r = q & 127, ntl = r >> 4, kt = r & 15; c.src = ldp(F, I_W2) + (size_t)e * DFF * DM; c.dst = F.ws + WS_W2 + (size_t)e * DM * DFF; c.ldn = DM; c.rowbytes = DFF; c.k0 = kt * 128; c.n0 = ntl * 256; c.kind = 3; }
        else if (t < NE * 384 + 128) { const int q = t - NE * 384, ntl = q >> 4, kt = q & 15;      c.src = ldp(F, I_W_OUT); c.dst = F.ws + WS_WOUT; c.ldn = DM; c.rowbytes = DM; c.k0 = kt * 128; c.n0 = ntl * 256; c.kind = 3; }
        else { const int q = t - (NE * 384 + 128), ntl = q >> 4, kt = q & 15;                      c.src = ldp(F, I_W_IN); c.dst = F.ws + WS_WIN8; c.ldn = DIN; c.rowbytes = DM; c.k0 = kt * 128; c.n0 = 4096 + ntl * 256; c.kind = 4; }
    }
    return c;
}
template <bool FP8> __device__ __forceinline__ void cvt_tiles(const Frame& F, const Args& A, int t0, int tstride, int tend) {
    constexpr int RPB = FP8 ? 16 : 8;
    LAS unsigned* T = (LAS unsigned*)F.lds;
    const int nq = F.tid & 63, kb = F.tid >> 6;
    f32x4 va[RPB], vb[RPB];
#define CVT_ISSUE(v, t_) do { if ((t_) < tend) { const CvtTile _c = cvt_decode<FP8>(F, A, (t_)); const float* _s = _c.src + (size_t)(_c.k0 + RPB * kb) * _c.ldn + _c.n0 + 4 * nq; \
        _Pragma("unroll") for (int r = 0; r < RPB; ++r) v[r] = __builtin_nontemporal_load((const f32x4*)(_s + (size_t)r * _c.ldn)); } } while (0)
#define CVT_PROCESS(v, t_, tnext_) do { const CvtTile _c = cvt_decode<FP8>(F, A, (t_)); \
        _Pragma("unroll") for (int g = 0; g < 4; ++g) _Pragma("unroll") for (int i = 0; i < 4; ++i) { unsigned u; \
            if constexpr (FP8) u = cvt4_fp8(v[4 * g][i] * FP8_BS, v[4 * g + 1][i] * FP8_BS, v[4 * g + 2][i] * FP8_BS, v[4 * g + 3][i] * FP8_BS); \
            else u = cvt_pk_bf16(v[2 * g][i], v[2 * g + 1][i]); \
            T[(4 * nq + i) * 33 + 4 * kb + g] = u; } \
        __syncthreads(); \
        CVT_ISSUE(v, (tnext_)); \
        { const int ch = F.tid & 7; \
        _Pragma("unroll") for (int j = 0; j < 4; ++j) { const int row = (F.tid >> 3) + 64 * j; \
            u32x4 o; o.x = T[row * 33 + 4 * ch]; o.y = T[row * 33 + 4 * ch + 1]; o.z = T[row * 33 + 4 * ch + 2]; o.w = T[row * 33 + 4 * ch + 3]; \
            const int drow = dest_row(_c.kind, _c.n0 + row); \
            u32x4* _p = (u32x4*)(_c.dst + (size_t)drow * _c.rowbytes + (size_t)_c.k0 * (FP8 ? 1 : 2) + 16 * ch); \
            if (_c.kind == 3 && FP8) *_p = o; else __builtin_nontemporal_store(o, _p); } } \
        __syncthreads(); } while (0)
    int t = t0; if (t >= tend) return;
    CVT_ISSUE(va, t); CVT_ISSUE(vb, t + tstride);
    for (;;) {
        CVT_PROCESS(va, t, t + 2 * tstride); t += tstride; if (t >= tend) break;
        CVT_PROCESS(vb, t, t + 2 * tstride); t += tstride; if (t >= tend) break;
    }
#undef CVT_ISSUE
#undef CVT_PROCESS
}
template <bool FP8> __device__ __forceinline__ void cvt_tiles_tp(const Frame& F, const Args& A, int t0, int tstride, int tend) {
    constexpr int RPB = FP8 ? 16 : 8;
    const int g = F.lane >> 3, j = F.lane & 7;
    f32x4 va[RPB], vb[RPB];
#define TP_ISSUE(v, t_) do { if ((t_) < tend) { const CvtTile _c = cvt_decode<FP8>(F, A, (t_)); const float* _s = _c.src + (size_t)(_c.k0 + RPB * g) * _c.ldn + _c.n0 + 32 * F.wave + 4 * j; \
        _Pragma("unroll") for (int r = 0; r < RPB; ++r) v[r] = __builtin_nontemporal_load((const f32x4*)(_s + (size_t)r * _c.ldn)); } } while (0)
#define TP_FINISH(v, t_) do { const CvtTile _c = cvt_decode<FP8>(F, A, (t_)); \
        _Pragma("unroll") for (int i = 0; i < 4; ++i) { u32x4 o; \
            if constexpr (FP8) { o.x = cvt4_fp8(v[0][i] * FP8_BS, v[1][i] * FP8_BS, v[2][i] * FP8_BS, v[3][i] * FP8_BS); o.y = cvt4_fp8(v[4][i] * FP8_BS, v[5][i] * FP8_BS, v[6][i] * FP8_BS, v[7][i] * FP8_BS); \
                o.z = cvt4_fp8(v[8 % RPB][i] * FP8_BS, v[9 % RPB][i] * FP8_BS, v[10 % RPB][i] * FP8_BS, v[11 % RPB][i] * FP8_BS); o.w = cvt4_fp8(v[12 % RPB][i] * FP8_BS, v[13 % RPB][i] * FP8_BS, v[14 % RPB][i] * FP8_BS, v[15 % RPB][i] * FP8_BS); } \
            else { o.x = cvt_pk_bf16(v[0][i], v[1][i]); o.y = cvt_pk_bf16(v[2][i], v[3][i]); o.z = cvt_pk_bf16(v[4][i], v[5][i]); o.w = cvt_pk_bf16(v[6][i], v[7][i]); } \
            const int drow = dest_row(_c.kind, _c.n0 + 32 * F.wave + 4 * j + i); \
            u32x4* _p = (u32x4*)(_c.dst + (size_t)drow * _c.rowbytes + (size_t)(_c.k0 + RPB * g) * (FP8 ? 1 : 2)); \
            if (_c.kind == 3 && FP8) *_p = o; else __builtin_nontemporal_store(o, _p); } } while (0)
    int t = t0; if (t >= tend) return;
    TP_ISSUE(va, t); TP_ISSUE(vb, t + tstride);
    for (;;) {
        TP_FINISH(va, t); TP_ISSUE(va, t + 2 * tstride); t += tstride; if (t >= tend) break;
        TP_FINISH(vb, t); TP_ISSUE(vb, t + 2 * tstride); t += tstride; if (t >= tend) break;
    }
#undef TP_ISSUE
#undef TP_FINISH
}
__device__ __forceinline__ void p0_prologue(const Frame& F, const Args& A) {
    constexpr int NADA = 6 * DM / 64;
    if (F.bx < NADA) {
        LAS float* tab = (LAS float*)F.lds;
        LAS float* red = (LAS float*)(F.lds + 98304);
        { const float* cp = ldp(F, I_C); const float* cc = ldp(F, I_C_CTX);
          float v[4][9];
#pragma unroll
          for (int j = 0; j < 4; ++j) { const int k = F.tid + 512 * j;
#pragma unroll
              for (int r = 0; r < 8; ++r) v[j][r] = cp[r * DM + k];
              v[j][8] = cc[k]; }
#pragma unroll
          for (int j = 0; j < 4; ++j) { const int k = F.tid + 512 * j;
              *(LAS f32x4*)(tab + k * 12) = (f32x4){siluf_(v[j][0]), siluf_(v[j][1]), siluf_(v[j][2]), siluf_(v[j][3])};
              *(LAS f32x4*)(tab + k * 12 + 4) = (f32x4){siluf_(v[j][4]), siluf_(v[j][5]), siluf_(v[j][6]), siluf_(v[j][7])};
              tab[k * 12 + 8] = siluf_(v[j][8]); } }
        __syncthreads();
        for (int u = F.bx; u < NADA; u += F.G) {
            const int col = u * 64 + F.lane; float acc[9];
#pragma unroll
            for (int r = 0; r < 9; ++r) acc[r] = 0.f;
            const float* wp = ldp(F, I_ADA_W) + (size_t)(F.wave * 256) * (6 * DM) + col;
            for (int k0 = 0; k0 < 256; k0 += 32) { float av[32];
#pragma unroll
                for (int j = 0; j < 32; ++j) av[j] = __builtin_nontemporal_load(wp + (size_t)(k0 + j) * (6 * DM));
#pragma unroll
                for (int j = 0; j < 32; ++j) { const float a = av[j]; const int k = F.wave * 256 + k0 + j;
                    const f32x4 s0 = *(const LAS f32x4*)(tab + k * 12), s1 = *(const LAS f32x4*)(tab + k * 12 + 4), s2 = *(const LAS f32x4*)(tab + k * 12 + 8);
                    acc[0] += a * s0[0]; acc[1] += a * s0[1]; acc[2] += a * s0[2]; acc[3] += a * s0[3]; acc[4] += a * s1[0]; acc[5] += a * s1[1]; acc[6] += a * s1[2]; acc[7] += a * s1[3]; acc[8] += a * s2[0]; } }
#pragma unroll
            for (int r = 0; r < 9; ++r) red[(F.wave * 9 + r) * 64 + F.lane] = acc[r];
            __syncthreads();
            for (int idx = F.tid; idx < 9 * 64; idx += 512) { const int r = idx >> 6, l = idx & 63; float s = 0.f;
#pragma unroll
                for (int w = 0; w < 8; ++w) s += red[(w * 9 + r) * 64 + l];
                ((float*)(F.ws + WS_MOD))[r * (6 * DM) + u * 64 + l] = s + ldp(F, I_ADA_B)[u * 64 + l]; }
            __syncthreads();
        }
    }
    for (int idx = F.bx * 512 + F.tid; idx < NE * DM; idx += F.G * 512) { const int e = idx / DM, k = idx % DM; ((bf16_t*)(F.ws + WS_RWT))[idx] = (bf16_t)(cvt_pk_bf16(ldp(F, I_ROUTER_W)[k * NE + e], 0.f) & 0xffffu); }
    if (F.G == 256) { if (F.bx < NADA) cvt_tiles_tp<false>(F, A, F.bx, NADA, 2 * NADA);
        else { cvt_tiles_tp<false>(F, A, 2 * NADA + (F.bx - NADA), 256 - NADA, 32 * 16); cvt_tiles_tp<true>(F, A, NE * 384 + (F.bx - NADA), 256 - NADA, NE * 384 + 256); } }
    else { cvt_tiles<false>(F, A, F.bx, F.G, 32 * 16); cvt_tiles<true>(F, A, NE * 384 + F.bx, F.G, NE * 384 + 256); }
}

__device__ __forceinline__ void p1_norm_mod(const Frame& F, const Args& A) {
    const float* mod = (const float*)(F.ws + WS_MOD);
    constexpr int NROWS = NTOK + NCTX;
    for (int row = F.bx * 8 + F.wave; row < NROWS; row += F.G * 8) {
        const bool isctx = row >= NTOK; const int r2 = isctx ? row - NTOK : row;
        const float* src = isctx ? ldp(F, I_CTX) + (size_t)r2 * DM : ldp(F, I_X) + (size_t)r2 * DM;
        bf16_t* dst = isctx ? (bf16_t*)(F.ws + WS_HCTX) + (size_t)r2 * DM : (bf16_t*)(F.ws + WS_HLAT) + (size_t)r2 * DM;
        const float* mrow = mod + (size_t)(isctx ? 8 : (r2 / SEQ)) * (6 * DM);
        f32x4 v[8]; float ss = 0.f;
#pragma unroll
        for (int j = 0; j < 8; ++j) { v[j] = __builtin_nontemporal_load((const f32x4*)(src + 4 * F.lane + 256 * j)); ss += v[j][0] * v[j][0] + v[j][1] * v[j][1] + v[j][2] * v[j][2] + v[j][3] * v[j][3]; }
        ss = wave_sum(ss); const float rstd = rsqrtf(ss * (1.0f / DM) + EPS);
#pragma unroll
        for (int j = 0; j < 8; ++j) { const int col = 4 * F.lane + 256 * j;
            const f32x4 w = *(const f32x4*)(ldp(F, I_PRE_MIX) + col), sh = *(const f32x4*)(mrow + col), sc = *(const f32x4*)(mrow + DM + col);
            f32x4 y;
#pragma unroll
            for (int i = 0; i < 4; ++i) y[i] = v[j][i] * rstd * w[i] * (1.0f + sc[i]) + sh[i];
            u32x2 o; o.x = cvt_pk_bf16(y[0], y[1]); o.y = cvt_pk_bf16(y[2], y[3]); *(u32x2*)(dst + col) = o;
            if (!isctx) *(unsigned*)(F.ws + WS_H8 + (size_t)r2 * DM + col) = cvt4_fp8(y[0] * FP8_AS, y[1] * FP8_AS, y[2] * FP8_AS, y[3] * FP8_AS); }
    }
}

struct SchedIn {
    int G, c, r0, nr; bool f8;
    __device__ __forceinline__ bool next(int i_, pg8::Unit& u) const {
        const int i = r0 + i_;
        const int nN = f8 ? 8 : 16, NLAT = 64 * nN; const long L = (long)i * G + c; int pm = 0, pn = 0, aux = 0; bool ok;
        if (i_ >= nr) { u.pm = 0; u.pn = 0; u.aux = 0; return false; }
        if (L < NLAT) { ok = pg8::static_order(64, nN, G, c, i, pm, pn); if (f8) pn += 16; }
        else if (!f8) { const int q = (int)(L - NLAT); ok = q < 64; aux = 1; pm = q & 7; pn = 4 + (q >> 3); }
        else ok = false;
        u.pm = pm; u.pn = pn; u.aux = aux; return ok; }
    __device__ __forceinline__ unsigned abase(const pg8::Unit& u) const { return f8 ? (unsigned)WS_H8 + (unsigned)u.pm * (256u * DM) : (unsigned)WS_HLAT + (unsigned)u.aux * (unsigned)(WS_HCTX - WS_HLAT) + (unsigned)u.pm * (256u * DM * 2u); }
    __device__ __forceinline__ unsigned bbase(const pg8::Unit& u) const { return f8 ? (unsigned)WS_WIN8 + (unsigned)(u.pn - 16) * (256u * DM) : (unsigned)WS_WIN + (unsigned)u.pn * (256u * DM * 2u); }
};
struct EpiGlu8 { unsigned char* ws;
    __device__ __forceinline__ void operator()(const f32x4 (&acc)[2][2][4][2], const pg8::Unit& u, int wr, int wc, int fr_, int fq_) const {
        const int ln_ = get_lane(); const int fr = ln_ & 15, fq = ln_ >> 4; (void)fr_; (void)fq_;
        const int row0 = u.pm * 256 + wr * 64 + fr, tl = u.pn - 16; bf16_t* base = (bf16_t*)(ws + WS_U);
#pragma unroll
        for (int ai = 0; ai < 2; ++ai)
#pragma unroll
            for (int m = 0; m < 4; ++m) { const int row = row0 + ai * 128 + m * 16; float o[8];
#pragma unroll
                for (int n = 0; n < 2; ++n)
#pragma unroll
                    for (int i = 0; i < 4; ++i) o[4 * n + i] = (acc[ai][0][m][n][i] * FP8_DESCALE) * sigmoidf_(acc[ai][1][m][n][i] * FP8_DESCALE);
                u32x4 w; w.x = cvt_pk_bf16(o[0], o[1]); w.y = cvt_pk_bf16(o[2], o[3]); w.z = cvt_pk_bf16(o[4], o[5]); w.w = cvt_pk_bf16(o[6], o[7]);
                *(u32x4*)(base + (unsigned)(row * DCONV + 128 * tl + 32 * wc + 8 * fq)) = w; } } };
struct EpiIn {
    unsigned char* ws;
    __device__ __forceinline__ void operator()(const f32x4 (&acc)[2][2][4][2], const pg8::Unit& u, int wr, int wc, int fr_, int fq_) const {
        const int ln_ = get_lane(); const int fr = ln_ & 15, fq = ln_ >> 4; (void)fr_; (void)fq_;
        const int row0 = u.pm * 256 + wr * 64 + fr;
        if (u.pn < 8) {
            const bool isq = u.pn < 4; const int pnl = u.pn & 3;
            bf16_t* base = (bf16_t*)(ws + (u.aux ? WS_KC : (isq ? WS_Q : WS_K)));
            const float scl = isq ? 0.08838834764831845f : 1.0f;
            const int j0 = 16 * wc + 4 * fq;
            float inv[4];
#pragma unroll
            for (int i = 0; i < 4; ++i) inv[i] = exp2f(-(float)(j0 + i) * (13.287712379549449f / 64.0f));
#pragma unroll
            for (int ai = 0; ai < 2; ++ai)
#pragma unroll
                for (int m = 0; m < 4; ++m) { const int row = row0 + ai * 128 + m * 16;
                    const float pos = u.aux ? (float)(row & (CTXL - 1)) : (float)(CTXL + (row & (SEQ - 1)));
                    f32x4 cs, sn;
#pragma unroll
                    for (int i = 0; i < 4; ++i) { float t = pos * inv[i] * 0.15915494309189535f; t = t - rintf(t); sn[i] = __builtin_amdgcn_sinf(t) * scl; cs[i] = __builtin_amdgcn_cosf(t) * scl; }
#pragma unroll
                    for (int bj = 0; bj < 2; ++bj) { const f32x4 t1 = acc[ai][bj][m][0], t2 = acc[ai][bj][m][1];
                        const f32x4 o1 = t1 * cs - t2 * sn, o2 = t1 * sn + t2 * cs;
                        bf16_t* p = base + (unsigned)(row * DRET + 128 * (2 * pnl + bj) + j0);
                        u32x2 w1; w1.x = cvt_pk_bf16(o1[0], o1[1]); w1.y = cvt_pk_bf16(o1[2], o1[3]); *(u32x2*)p = w1;
                        u32x2 w2; w2.x = cvt_pk_bf16(o2[0], o2[1]); w2.y = cvt_pk_bf16(o2[2], o2[3]); *(u32x2*)(p + 64) = w2; } }
        } else if (u.pn < 16) {
            const bool isv = u.pn < 12; const int pnl = u.pn & 3;
            bf16_t* base = (bf16_t*)(ws + (u.aux ? WS_VC : (isv ? WS_V : WS_G)));
#pragma unroll
            for (int ai = 0; ai < 2; ++ai)
#pragma unroll
                for (int m = 0; m < 4; ++m) { const int row = row0 + ai * 128 + m * 16;
#pragma unroll
                    for (int bj = 0; bj < 2; ++bj) { f32x4 a = acc[ai][bj][m][0], b = acc[ai][bj][m][1];
                        if (!isv) {
#pragma unroll
                            for (int i = 0; i < 4; ++i) { a[i] = siluf_(a[i]); b[i] = siluf_(b[i]); } }
                        u32x4 w; w.x = cvt_pk_bf16(a[0], a[1]); w.y = cvt_pk_bf16(a[2], a[3]); w.z = cvt_pk_bf16(b[0], b[1]); w.w = cvt_pk_bf16(b[2], b[3]);
                        *(u32x4*)(base + (unsigned)(row * DRET + 256 * pnl + 128 * bj + 32 * wc + 8 * fq)) = w; } }
        } else {
            const int tl = u.pn - 16; bf16_t* base = (bf16_t*)(ws + WS_U);
#pragma unroll
            for (int ai = 0; ai < 2; ++ai)
#pragma unroll
                for (int m = 0; m < 4; ++m) { const int row = row0 + ai * 128 + m * 16; float o[8];
#pragma unroll
                    for (int n = 0; n < 2; ++n)
#pragma unroll
                        for (int i = 0; i < 4; ++i) o[4 * n + i] = acc[ai][0][m][n][i] * sigmoidf_(acc[ai][1][m][n][i]);
                    u32x4 w; w.x = cvt_pk_bf16(o[0], o[1]); w.y = cvt_pk_bf16(o[2], o[3]); w.z = cvt_pk_bf16(o[4], o[5]); w.w = cvt_pk_bf16(o[6], o[7]);
                    *(u32x4*)(base + (unsigned)(row * DCONV + 128 * tl + 32 * wc + 8 * fq)) = w; }
        }
    }
};

constexpr int IMGP = 272, IMGB = 128 * IMGP;
__device__ __forceinline__ unsigned img_row_base(unsigned lane) { return (lane & 15) * IMGP + 16 * (lane >> 4); }
__device__ __forceinline__ unsigned img_tr_base(unsigned lane) { return (8 * (lane >> 4) + ((lane & 15) >> 2)) * IMGP + 8 * (lane & 3); }
__device__ __forceinline__ bf16x8 tr_frag(const LAS unsigned char* img, unsigned trb, int c, int ks) {
    const s16x4 a = __builtin_amdgcn_ds_read_tr16_b64_v4i16((LAS s16x4*)(img + trb + ks * 32 * IMGP + c * 32));
    const s16x4 b = __builtin_amdgcn_ds_read_tr16_b64_v4i16((LAS s16x4*)(img + trb + ks * 32 * IMGP + 4 * IMGP + c * 32));
    bf16x8 r; r[0] = a[0]; r[1] = a[1]; r[2] = a[2]; r[3] = a[3]; r[4] = b[0]; r[5] = b[1]; r[6] = b[2]; r[7] = b[3]; return r; }

__device__ __forceinline__ void p3_state_unit(const Frame& F, const Args& A, int unit) {
    const int eh = unit & 1, dir = (unit >> 1) & 1, bh = unit >> 2, b = bh >> 3, h = bh & 7;
    const float lg = log_sigmoid_(dir ? ldp(F, I_DEC_B)[h] : ldp(F, I_DEC_F)[h]);
    const float dchunk = __expf(lg * (float)CHUNK);
    static_assert(4 * IMGB <= RING_BYTES, "state scan LDS"); LAS unsigned char* Kimg = F.lds;
    bf16_t* ST = (bf16_t*)(F.ws + (dir ? WS_SB : WS_SF)) + (size_t)bh * NCHUNK * HD * HD;
    const bf16_t* kl = (const bf16_t*)(F.ws + WS_K); const bf16_t* vl = (const bf16_t*)(F.ws + WS_V);
    const bf16_t* kc = (const bf16_t*)(F.ws + WS_KC); const bf16_t* vc = (const bf16_t*)(F.ws + WS_VC);
    f32x4 acc[4];
#pragma unroll
    for (int c = 0; c < 4; ++c) acc[c] = (f32x4){0.f, 0.f, 0.f, 0.f};
    int lane = F.lane; const int w = F.wave;
    asm volatile("" : "+v"(lane));
    const unsigned trb = img_tr_base((unsigned)lane);
    u32x4 kreg[4], vreg[2];
#define P3_LOAD(step_) do { const int _s = (step_); const bool _ic = _s < 2; const int _ci = _ic ? (dir ? 1 - _s : _s) : (dir ? 17 - _s : _s - 2); \
        const size_t _t0 = _ic ? (size_t)b * CTXL + _ci * CHUNK : (size_t)b * SEQ + _ci * CHUNK; \
        const bf16_t* _ks = (_ic ? kc : kl) + _t0 * DRET + h * HD; const bf16_t* _vs = (_ic ? vc : vl) + _t0 * DRET + h * HD + 64 * eh; \
        _Pragma("unroll") for (int j = 0; j < 4; ++j) { const int idx = F.tid + 512 * j; kreg[j] = *(const u32x4*)(_ks + (size_t)(idx >> 4) * DRET + (idx & 15) * 8); } \
        _Pragma("unroll") for (int j = 0; j < 2; ++j) { const int idx = F.tid + 512 * j; vreg[j] = *(const u32x4*)(_vs + (size_t)(idx >> 3) * DRET + (idx & 7) * 8); } } while (0)
#define P3_WRITE(step_) do { LAS unsigned char* _K = Kimg + ((step_) & 1) * 2 * IMGB; LAS unsigned char* _V = _K + IMGB; \
        _Pragma("unroll") for (int j = 0; j < 4; ++j) { const int idx = F.tid + 512 * j; *(LAS u32x4*)(_K + (idx >> 4) * IMGP + (idx & 15) * 16) = kreg[j]; } \
        _Pragma("unroll") for (int j = 0; j < 2; ++j) { const int idx = F.tid + 512 * j, row = idx >> 3, ch = 8 * eh + (idx & 7); const u32x4 vv = vreg[j]; \
            const float wt = __expf(lg * (float)(dir ? row : (CHUNK - 1 - row)));                \
            u32x4 o; o.x = cvt_pk_bf16(bf_lo(vv.x) * wt, bf_hi(vv.x) * wt); o.y = cvt_pk_bf16(bf_lo(vv.y) * wt, bf_hi(vv.y) * wt); \
            o.z = cvt_pk_bf16(bf_lo(vv.z) * wt, bf_hi(vv.z) * wt); o.w = cvt_pk_bf16(bf_lo(vv.w) * wt, bf_hi(vv.w) * wt); \
            *(LAS u32x4*)(_V + row * IMGP + ch * 16) = o; } } while (0)
    __syncthreads();
    P3_LOAD(0); P3_WRITE(0); P3_LOAD(1);
    __syncthreads();
    for (int step = 0; step < 18; ++step) {
        const bool isctx = step < 2; const int ci = isctx ? (dir ? 1 - step : step) : (dir ? 17 - step : step - 2);
        if (!isctx) {
#pragma unroll
            for (int c = 0; c < 4; ++c) { const int e = 64 * eh + 16 * c + (lane & 15), d0 = 16 * w + 4 * (lane >> 4);
                u32x2 o; o.x = cvt_pk_bf16(acc[c][0], acc[c][1]); o.y = cvt_pk_bf16(acc[c][2], acc[c][3]);
                *(u32x2*)(ST + ((size_t)ci * HD + e) * HD + d0) = o; }
            if (step == 17) break;
        }
        if (step + 1 < 17) { P3_WRITE(step + 1); if (step + 2 < 17) P3_LOAD(step + 2); }
        { LAS unsigned char* Kc = Kimg + (step & 1) * 2 * IMGB; LAS unsigned char* Vc = Kc + IMGB;
#pragma unroll
        for (int c = 0; c < 4; ++c) { acc[c][0] *= dchunk; acc[c][1] *= dchunk; acc[c][2] *= dchunk; acc[c][3] *= dchunk; }
#pragma unroll
        for (int ks = 0; ks < 4; ++ks) { const bf16x8 af = tr_frag(Kc, trb, w, ks);
#pragma unroll
            for (int c = 0; c < 4; ++c) { const bf16x8 bfr = tr_frag(Vc, trb, 4 * eh + c, ks);
                acc[c] = __builtin_amdgcn_mfma_f32_16x16x32_bf16(af, bfr, acc[c], 0, 0, 0); } } }
        __syncthreads();
    }
#undef P3_WRITE
#undef P3_LOAD
    __syncthreads();
}

__device__ __forceinline__ void p3_conv_unit(const Frame& F, const Args& A, int sq) {
    LAS bf16_t* T = (LAS bf16_t*)F.lds;
    const size_t tok0 = (size_t)sq * GRIDW;
    const bf16_t* usrc = (const bf16_t*)(F.ws + WS_U) + tok0 * DCONV;
    __syncthreads();
#pragma unroll
    for (int j = 0; j < 16; ++j) { const int idx = F.tid + 512 * j; *(LAS u32x4*)(F.lds + idx * 16) = __builtin_nontemporal_load((const u32x4*)(usrc + (size_t)idx * 8)); }
    __syncthreads();
    {
        const int ch = 2 * F.tid;
        f32x2 wv[CONVW];
#pragma unroll
        for (int t = 0; t < CONVW; ++t) wv[t] = *(const f32x2*)(ldp(F, I_CONV_W) + t * DCONV + ch);
        const f32x2 bias = *(const f32x2*)(ldp(F, I_CONV_B) + ch);
        f32x2 prev[16];
#pragma unroll
        for (int i = 0; i < 16; ++i) prev[i] = (f32x2){0.f, 0.f};
        for (int cb = 0; cb < 4; ++cb) {
            const int p0 = cb * 16; f32x2 a[16];
#pragma unroll
            for (int i = 0; i < 16; ++i) a[i] = bias;
#pragma unroll
            for (int qb = 0; qb < 6; ++qb) { f32x2 xin[8];
#pragma unroll
                for (int k = 0; k < 8; ++k) { const int qq = qb * 8 + k, q = p0 - CONVP + qq; const bool ok = (qq < 46) && (q >= 0) && (q < GRIDW);
                    const unsigned uu = ok ? *(const LAS unsigned*)(T + (ok ? q : 0) * DCONV + ch) : 0u; xin[k] = (f32x2){bf_lo(uu), bf_hi(uu)}; }
#pragma unroll
                for (int k = 0; k < 8; ++k) { const int qq = qb * 8 + k;
#pragma unroll
                    for (int i = 0; i < 16; ++i) { const int tap = qq - i;
                        if (qq < 46 && tap >= 0 && tap < CONVW) a[i] += wv[tap] * xin[k]; } }
                asm volatile("" ::: "memory"); }
            if (cb > 0) {
#pragma unroll
                for (int i = 0; i < 16; ++i) *(LAS unsigned*)(T + (p0 - 16 + i) * DCONV + ch) = cvt_pk_bf16(prev[i][0], prev[i][1]); }
#pragma unroll
            for (int i = 0; i < 16; ++i) prev[i] = a[i];
        }
#pragma unroll
        for (int i = 0; i < 16; ++i) *(LAS unsigned*)(T + (48 + i) * DCONV + ch) = cvt_pk_bf16(prev[i][0], prev[i][1]);
    }
    __syncthreads();
    float lw[16], lb[16];
#pragma unroll
    for (int i = 0; i < 16; ++i) { lw[i] = ldp(F, I_LN_W)[16 * F.lane + i]; lb[i] = ldp(F, I_LN_B)[16 * F.lane + i]; }
    unsigned char* ydst = F.ws + WS_Y;
    for (int p = F.wave; p < GRIDW; p += 8) {
        const u32x4 r0 = *(const LAS u32x4*)(F.lds + p * 2048 + F.lane * 32), r1 = *(const LAS u32x4*)(F.lds + p * 2048 + F.lane * 32 + 16);
        float v[16]; const unsigned rr[8] = {r0.x, r0.y, r0.z, r0.w, r1.x, r1.y, r1.z, r1.w};
#pragma unroll
        for (int i = 0; i < 8; ++i) { v[2 * i] = bf_lo(rr[i]); v[2 * i + 1] = bf_hi(rr[i]); }
        float s = 0.f;
#pragma unroll
        for (int i = 0; i < 16; ++i) s += v[i];
        const float mu = wave_sum(s) * (1.0f / DCONV); float q = 0.f;
#pragma unroll
        for (int i = 0; i < 16; ++i) { const float d = v[i] - mu; q += d * d; }
        const float rstd = rsqrtf(wave_sum(q) * (1.0f / DCONV) + EPS);
        float yv[16];
#pragma unroll
        for (int i = 0; i < 16; ++i) yv[i] = siluf_((v[i] - mu) * rstd * lw[i] + lb[i]) * FP8_AS;
        *(u32x4*)(ydst + (tok0 + p) * DM + DRET + 16 * F.lane) = (u32x4){cvt4_fp8(yv[0], yv[1], yv[2], yv[3]), cvt4_fp8(yv[4], yv[5], yv[6], yv[7]), cvt4_fp8(yv[8], yv[9], yv[10], yv[11]), cvt4_fp8(yv[12], yv[13], yv[14], yv[15])};
    }
    __syncthreads();
}

__device__ __forceinline__ void p4_retention(const Frame& F, const Args& A) {
    static_assert(4 * IMGB <= RING_BYTES, "retention phase LDS");
    const int lane0 = F.lane, w = F.wave;
    LAS unsigned char* Kimg = F.lds; LAS unsigned char* Vimg = F.lds + IMGB; LAS unsigned char* Bimg = F.lds + 2 * IMGB; LAS unsigned char* Pimg = F.lds + 3 * IMGB + w * (16 * IMGP);
    const bf16_t* kall = (const bf16_t*)(F.ws + WS_K); const bf16_t* vall = (const bf16_t*)(F.ws + WS_V); const bf16_t* qall = (const bf16_t*)(F.ws + WS_Q);
    u32x4 kreg[4], vreg[4]; bf16x8 qn[4];
#define P4_LOAD(u_) do { const int _ci = (u_) & 15, _bh = (u_) >> 4; const size_t _o = ((size_t)(_bh >> 3) * SEQ + _ci * CHUNK) * DRET + (_bh & 7) * HD; \
        _Pragma("unroll") for (int j = 0; j < 4; ++j) { const int idx = (w * 64 + lane) + 512 * j; kreg[j] = *(const u32x4*)(kall + _o + (size_t)(idx >> 4) * DRET + (idx & 15) * 8); vreg[j] = *(const u32x4*)(vall + _o + (size_t)(idx >> 4) * DRET + (idx & 15) * 8); } \
        _Pragma("unroll") for (int ks = 0; ks < 4; ++ks) qn[ks] = *(const bf16x8*)(qall + _o + (size_t)(16 * w + (lane & 15)) * DRET + 32 * ks + 8 * (lane >> 4)); } while (0)
    int unit = F.bx;
    { const int lane = lane0; if (unit < 1024) P4_LOAD(unit); }
    for (; unit < 1024; unit += F.G) {
        int lane = lane0; asm volatile("" : "+v"(lane));
        const unsigned rwb = img_row_base((unsigned)lane), trb = img_tr_base((unsigned)lane);
        const int ci = unit & 15, bh = unit >> 4, b = bh >> 3, h = bh & 7;
        const float lgf = log_sigmoid_(ldp(F, I_DEC_F)[h]), lgb = log_sigmoid_(ldp(F, I_DEC_B)[h]);
        const float lf2 = lgf * 1.4426950408889634f, lb2 = lgb * 1.4426950408889634f;
        const size_t tok0 = (size_t)b * SEQ + ci * CHUNK;
        __syncthreads();
#pragma unroll
        for (int j = 0; j < 4; ++j) { const int idx = F.tid + 512 * j; *(LAS u32x4*)(Kimg + (idx >> 4) * IMGP + (idx & 15) * 16) = kreg[j]; *(LAS u32x4*)(Vimg + (idx >> 4) * IMGP + (idx & 15) * 16) = vreg[j]; }
        bf16x8 qf[4];
#pragma unroll
        for (int ks = 0; ks < 4; ++ks) qf[ks] = qn[ks];
        const bf16_t* sfp = (const bf16_t*)(F.ws + WS_SF) + ((size_t)bh * NCHUNK + ci) * HD * HD; const bf16_t* sbp = (const bf16_t*)(F.ws + WS_SB) + ((size_t)bh * NCHUNK + ci) * HD * HD;
        u32x4 sfr[4], sbr[4];
#pragma unroll
        for (int j = 0; j < 4; ++j) { const int idx = F.tid + 512 * j; sfr[j] = __builtin_nontemporal_load((const u32x4*)(sfp + (size_t)idx * 8)); sbr[j] = __builtin_nontemporal_load((const u32x4*)(sbp + (size_t)idx * 8)); }
        __syncthreads();
        const int tl = 16 * w + (lane & 15);
#pragma unroll
        for (int c = 0; c < 8; ++c) { f32x4 sc = (f32x4){0.f, 0.f, 0.f, 0.f};
#pragma unroll
            for (int ks = 0; ks < 4; ++ks) { const bf16x8 kf = *(const LAS bf16x8*)(Kimg + rwb + c * 16 * IMGP + ks * 64); sc = __builtin_amdgcn_mfma_f32_16x16x32_bf16(kf, qf[ks], sc, 0, 0, 0); }
            float p[4];
#pragma unroll
            for (int r = 0; r < 4; ++r) { const int s = 16 * c + 4 * (lane >> 4) + r, dt = tl - s;
                const float df = (dt >= 0) ? __builtin_amdgcn_exp2f(lf2 * (float)dt) : 0.f, db = (dt <= 0) ? __builtin_amdgcn_exp2f(lb2 * (float)(-dt)) : 0.f;
                p[r] = sc[r] * (df + db); }
            u32x2 o; o.x = cvt_pk_bf16(p[0], p[1]); o.y = cvt_pk_bf16(p[2], p[3]);
            *(LAS u32x2*)(Pimg + (lane & 15) * IMGP + 32 * c + 8 * (lane >> 4)) = o; }
        __syncthreads();
#pragma unroll
        for (int j = 0; j < 4; ++j) { const int idx = F.tid + 512 * j; *(LAS u32x4*)(Kimg + (idx >> 4) * IMGP + (idx & 15) * 16) = sfr[j]; *(LAS u32x4*)(Bimg + (idx >> 4) * IMGP + (idx & 15) * 16) = sbr[j]; }
        __syncthreads();
        if (unit + F.G < 1024) P4_LOAD(unit + F.G);
        const bf16_t* gsrc = (const bf16_t*)(F.ws + WS_G) + (tok0 + tl) * DRET + h * HD;
        u32x2 gg[8];
#pragma unroll
        for (int c = 0; c < 8; ++c) gg[c] = __builtin_nontemporal_load((const u32x2*)(gsrc + 16 * c + 4 * (lane >> 4)));
        bf16x8 pf[4];
#pragma unroll
        for (int ks = 0; ks < 4; ++ks) pf[ks] = *(const LAS bf16x8*)(Pimg + rwb + ks * 64);
        const float af = __expf(lgf * (float)(tl + 1)), ab = __expf(lgb * (float)(CHUNK - tl));
        f32x4 o[8];
#pragma unroll
        for (int c = 0; c < 8; ++c) { f32x4 a = (f32x4){0.f, 0.f, 0.f, 0.f}, f = a, g = a;
#pragma unroll
            for (int ks = 0; ks < 4; ++ks) { const bf16x8 vf = tr_frag(Vimg, trb, c, ks); a = __builtin_amdgcn_mfma_f32_16x16x32_bf16(vf, pf[ks], a, 0, 0, 0); }
#pragma unroll
            for (int ks = 0; ks < 4; ++ks) { const bf16x8 s1 = *(const LAS bf16x8*)(Kimg + rwb + c * 16 * IMGP + ks * 64); f = __builtin_amdgcn_mfma_f32_16x16x32_bf16(s1, qf[ks], f, 0, 0, 0); }
#pragma unroll
            for (int ks = 0; ks < 4; ++ks) { const bf16x8 s2 = *(const LAS bf16x8*)(Bimg + rwb + c * 16 * IMGP + ks * 64); g = __builtin_amdgcn_mfma_f32_16x16x32_bf16(s2, qf[ks], g, 0, 0, 0); }
#pragma unroll
            for (int r = 0; r < 4; ++r) o[c][r] = a[r] + af * f[r] + ab * g[r]; }
        float s = 0.f;
#pragma unroll
        for (int c = 0; c < 8; ++c) s += (o[c][0] + o[c][1]) + (o[c][2] + o[c][3]);
        s += __shfl_xor(s, 16); s += __shfl_xor(s, 32);
        const float mu = s * (1.0f / HD); float q2 = 0.f;
#pragma unroll
        for (int c = 0; c < 8; ++c)
#pragma unroll
            for (int r = 0; r < 4; ++r) { const float d = o[c][r] - mu; q2 += d * d; }
        q2 += __shfl_xor(q2, 16); q2 += __shfl_xor(q2, 32);
        const float rstd = rsqrtf(q2 * (1.0f / HD) + GN_EPS);
        unsigned char* ydst = F.ws + WS_Y + (tok0 + tl) * DM + h * HD;
        const float* gnw = ldp(F, I_GN_W) + h * HD;
#pragma unroll
        for (int c = 0; c < 8; ++c) { const int e0 = 16 * c + 4 * (lane >> 4);
            const f32x4 gw = *(const f32x4*)(gnw + e0);
            const float y0 = (o[c][0] - mu) * rstd * gw[0] * bf_lo(gg[c].x), y1 = (o[c][1] - mu) * rstd * gw[1] * bf_hi(gg[c].x), y2 = (o[c][2] - mu) * rstd * gw[2] * bf_lo(gg[c].y), y3 = (o[c][3] - mu) * rstd * gw[3] * bf_hi(gg[c].y);
            *(unsigned*)(ydst + e0) = cvt4_fp8(y0 * FP8_AS, y1 * FP8_AS, y2 * FP8_AS, y3 * FP8_AS); }
    }
#undef P4_LOAD
    __syncthreads();
}

struct SchedDense { unsigned a, bt; int nM, nN, G, c; unsigned RB; int r0, nr;
    __device__ __forceinline__ bool next(int i, pg8::Unit& u) const { u.aux = 0; int pm = 0, pn = 0; const bool ok = (i < nr) && pg8::static_order(nM, nN, G, c, r0 + i, pm, pn); u.pm = pm; u.pn = pn; return ok; }
    __device__ __forceinline__ unsigned abase(const pg8::Unit& u) const { return a + (unsigned)u.pm * 256u * RB; }
    __device__ __forceinline__ unsigned bbase(const pg8::Unit& u) const { return bt + (unsigned)u.pn * 256u * RB; } };
struct EpiBf16 { bf16_t* C; int ldc; float sc;
    __device__ __forceinline__ void operator()(const f32x4 (&acc)[2][2][4][2], const pg8::Unit& u, int wr, int wc, int fr_, int fq_) const {
        const int ln_ = get_lane(); const int fr = ln_ & 15, fq = ln_ >> 4; (void)fr_; (void)fq_;
        const int row0 = u.pm * 256 + wr * 64 + fr, col0 = u.pn * 256 + wc * 32 + 8 * fq;
#pragma unroll
        for (int ai = 0; ai < 2; ++ai)
#pragma unroll
            for (int m = 0; m < 4; ++m) { bf16_t* rowp = C + (unsigned)((row0 + ai * 128 + m * 16) * ldc + col0);
#pragma unroll
                for (int bj = 0; bj < 2; ++bj) { const f32x4 a = acc[ai][bj][m][0] * sc, b = acc[ai][bj][m][1] * sc;
                    u32x4 w; w.x = cvt_pk_bf16(a[0], a[1]); w.y = cvt_pk_bf16(a[2], a[3]); w.z = cvt_pk_bf16(b[0], b[1]); w.w = cvt_pk_bf16(b[2], b[3]);
                    *(u32x4*)(rowp + bj * 128) = w; } } } };

__device__ __forceinline__ void p6_mid(const Frame& F, const Args& A) {
    constexpr int PITCH = 4112;
    LAS unsigned char* tile = F.lds;
    LAS float* red = (LAS float*)(F.lds + 16 * PITCH);
    LAS int* lcnt = (LAS int*)(red + 8 * 16 * 32);
    LAS int* lbase = lcnt + 32;
    LAS int* tk_e = lbase + 32;
    LAS int* tk_ls = tk_e + 256;
    LAS float* PW = (LAS float*)(tk_ls + 256); LAS float* FW = PW + DM; LAS float* MODB = FW + DM;
    static_assert(16 * 4112 + 8 * 16 * 32 * 4 + (32 + 32 + 256 + 256) * 4 + 5 * DM * 4 <= RING_BYTES, "P6 LDS");
    const float* mod = (const float*)(F.ws + WS_MOD); const bf16_t* mix = (const bf16_t*)(F.ws + WS_MIX);
    bf16_t* x1p = (bf16_t*)(F.ws + WS_X1); unsigned char* h2p = F.ws + WS_H2;       const bf16_t* rwt = (const bf16_t*)(F.ws + WS_RWT);
    int* toke = (int*)(F.ws + WS_TOKE); float* tokg = (float*)(F.ws + WS_TOKG); int* toks = (int*)(F.ws + WS_TOKS); int* list = (int*)(F.ws + WS_LIST);
    const float* xin = ldp(F, I_X); const float* post_mix = ldp(F, I_POST_MIX); const float* pre_ffn = ldp(F, I_PRE_FFN);
    const int lane = F.lane, w = F.wave;
    if (F.tid < 32) lcnt[F.tid] = 0;
    { const f32x4 a = *(const f32x4*)(post_mix + 4 * F.tid), b = *(const f32x4*)(pre_ffn + 4 * F.tid); *(LAS f32x4*)(PW + 4 * F.tid) = a; *(LAS f32x4*)(FW + 4 * F.tid) = b; }
    __syncthreads();
    constexpr int NT = NTOK / 16;
    u32x2 mv[2][8]; f32x4 xv[2][8];
#define P6_LOAD(it_) do { _Pragma("unroll") for (int rr = 0; rr < 2; ++rr) { const size_t ro = (size_t)((it_) * 16 + 2 * w + rr) * DM + 4 * lane; \
        _Pragma("unroll") for (int j = 0; j < 8; ++j) { mv[rr][j] = *(const u32x2*)(mix + ro + 256 * j); xv[rr][j] = __builtin_nontemporal_load((const f32x4*)(xin + ro + 256 * j)); } } } while (0)
    const __amdgpu_buffer_rsrc_t rsm = __builtin_amdgcn_make_buffer_rsrc((void*)F.ws, 0, -1, 0x00020000);
#define P6_LOADM(it_) do { const unsigned _so = (unsigned)WS_MOD + (unsigned)(((it_) * 16) / SEQ) * (unsigned)(6 * DM * 4) + (unsigned)(2 * DM * 4) + (unsigned)w * 1024u; \
        _Pragma("unroll") for (int k = 0; k < 3; ++k) __builtin_amdgcn_raw_ptr_buffer_load_lds(rsm, (LAS void*)((LAS unsigned char*)MODB + k * (DM * 4) + w * 1024), 16, (unsigned)lane * 16u, _so + (unsigned)(k * DM * 4), 0, 0); } while (0)
    int it = F.bx, ti = 0;
    if (it < NT) { P6_LOADM(it); P6_LOAD(it); }
    for (; it < NT; it += F.G, ++ti) {
        const int r0 = it * 16;
        float r1[2], r2[2], ss2[2] = {0.f, 0.f};
#pragma unroll
        for (int rr = 0; rr < 2; ++rr) { float ss = 0.f;
#pragma unroll
            for (int j = 0; j < 8; ++j) { const float m0 = bf_lo(mv[rr][j].x), m1 = bf_hi(mv[rr][j].x), m2 = bf_lo(mv[rr][j].y), m3 = bf_hi(mv[rr][j].y); ss += m0 * m0 + m1 * m1 + m2 * m2 + m3 * m3; }
            r1[rr] = rsqrtf(wave_sum(ss) * (1.0f / DM) + EPS); }
        asm volatile("s_waitcnt vmcnt(0)" ::: "memory");
        __syncthreads();
#pragma unroll
        for (int j = 0; j < 8; ++j) { const int col = 4 * lane + 256 * j; const f32x4 pw = *(const LAS f32x4*)(PW + col), g1 = *(const LAS f32x4*)(MODB + col);
#pragma unroll
            for (int rr = 0; rr < 2; ++rr) { unsigned m0_ = mv[rr][j].x, m1_ = mv[rr][j].y; asm volatile("" : "+v"(m0_), "+v"(m1_));
                const float mm[4] = {bf_lo(m0_), bf_hi(m0_), bf_lo(m1_), bf_hi(m1_)};
#pragma unroll
                for (int i = 0; i < 4; ++i) { xv[rr][j][i] += g1[i] * (mm[i] * r1[rr] * pw[i]); ss2[rr] += xv[rr][j][i] * xv[rr][j][i]; }
                u32x2 xo; xo.x = cvt_pk_bf16(xv[rr][j][0], xv[rr][j][1]); xo.y = cvt_pk_bf16(xv[rr][j][2], xv[rr][j][3]);
                __builtin_nontemporal_store(xo, (u32x2*)(x1p + (size_t)(r0 + 2 * w + rr) * DM + col)); }
            asm volatile("" ::: "memory"); }
#pragma unroll
        for (int rr = 0; rr < 2; ++rr) r2[rr] = rsqrtf(wave_sum(ss2[rr]) * (1.0f / DM) + EPS);
#pragma unroll
        for (int j = 0; j < 8; ++j) { const int col = 4 * lane + 256 * j; const f32x4 fw = *(const LAS f32x4*)(FW + col), sh = *(const LAS f32x4*)(MODB + DM + col), sc = *(const LAS f32x4*)(MODB + 2 * DM + col);
#pragma unroll
            for (int rr = 0; rr < 2; ++rr) { const int rl = 2 * w + rr; float y[4];
#pragma unroll
                for (int i = 0; i < 4; ++i) y[i] = xv[rr][j][i] * r2[rr] * fw[i] * (1.0f + sc[i]) + sh[i];
                u32x2 o; o.x = cvt_pk_bf16(y[0], y[1]); o.y = cvt_pk_bf16(y[2], y[3]);
                *(unsigned*)(h2p + (size_t)(r0 + rl) * DM + col) = cvt4_fp8(y[0] * FP8_AS, y[1] * FP8_AS, y[2] * FP8_AS, y[3] * FP8_AS); *(LAS u32x2*)(tile + rl * PITCH + col * 2) = o; }
            asm volatile("" ::: "memory"); }
        __syncthreads();
        { f32x4 c0 = (f32x4){0.f, 0.f, 0.f, 0.f}, c1 = c0; bf16x8 b0[8], b1[8];
#pragma unroll
            for (int ks = 0; ks < 8; ++ks) { const int k0 = 256 * w + 32 * ks + 8 * (lane >> 4);
                b0[ks] = *(const bf16x8*)(rwt + (size_t)(lane & 15) * DM + k0); b1[ks] = *(const bf16x8*)(rwt + (size_t)(16 + (lane & 15)) * DM + k0); }
            asm volatile("" ::: "memory");
            if (it + F.G < NT) { P6_LOADM(it + F.G); P6_LOAD(it + F.G); }
            asm volatile("" ::: "memory");
#pragma unroll
            for (int ks = 0; ks < 8; ++ks) { const int k0 = 256 * w + 32 * ks + 8 * (lane >> 4);
                const bf16x8 a = *(const LAS bf16x8*)(tile + (lane & 15) * PITCH + k0 * 2);
                c0 = __builtin_amdgcn_mfma_f32_16x16x32_bf16(a, b0[ks], c0, 0, 0, 0); c1 = __builtin_amdgcn_mfma_f32_16x16x32_bf16(a, b1[ks], c1, 0, 0, 0); }
#pragma unroll
            for (int r = 0; r < 4; ++r) { red[(w * 16 + 4 * (lane >> 4) + r) * 32 + (lane & 15)] = c0[r]; red[(w * 16 + 4 * (lane >> 4) + r) * 32 + 16 + (lane & 15)] = c1[r]; } }
        __syncthreads();
        { const int rl = 2 * w + (lane >> 5), e = lane & 31, row = r0 + rl; float val = ldp(F, I_ROUTER_B)[e];
#pragma unroll
            for (int ww = 0; ww < 8; ++ww) val += red[(ww * 16 + rl) * 32 + e];
            float v[4]; int ix[4];
#pragma unroll
            for (int k = 0; k < 4; ++k) { float bv = val; int bi = e;
#pragma unroll
                for (int o = 1; o < 32; o <<= 1) { const float ov = __shfl_xor(bv, o); const int oi = __shfl_xor(bi, o); if (ov > bv || (ov == bv && oi < bi)) { bv = ov; bi = oi; } }
                v[k] = bv; ix[k] = bi; if (e == bi) val = -3.0e38f; }
            float gt[4], sum = 0.f;
#pragma unroll
            for (int k = 0; k < 4; ++k) { gt[k] = __expf(v[k] - v[0]); sum += gt[k]; }
            const float rs = 1.0f / sum;
#pragma unroll
            for (int k = 0; k < 4; ++k) if (e == ix[k]) { const int ls = atomicAdd((int*)&lcnt[e], 1); const int t = (ti * 16 + rl) * 4 + k;
                tk_e[t] = e; tk_ls[t] = ls; toke[row * 4 + k] = e; tokg[row * 4 + k] = gt[k] * rs; } }
    }
#undef P6_LOAD
#undef P6_LOADM
    __syncthreads();
    if (F.tid < 32) { const int n = lcnt[F.tid]; int base = 0; if (n > 0) base = (int)__hip_atomic_fetch_add(F.ctl + CW_CNT + 64 * F.tid, (unsigned)n, __ATOMIC_RELAXED, __HIP_MEMORY_SCOPE_AGENT); lbase[F.tid] = base; }
    __syncthreads();
    if (F.tid < ti * 64) { const int t = F.tid, tt = t >> 2, k = t & 3, e = tk_e[t], slot = lbase[e] + tk_ls[t], row = (F.bx + (tt >> 4) * F.G) * 16 + (tt & 15);
        toks[row * 4 + k] = slot; list[e * NTOK + slot] = row; }
    __syncthreads();
}

__device__ __forceinline__ int moe_tables(const Frame& F, int nN) {
    LAS int* toff = (LAS int*)(F.lds + MISC_OFF + 64); LAS int* cnt = (LAS int*)(F.lds + MISC_OFF + 256); LAS int* utab = (LAS int*)(F.lds + MISC_OFF + 512);
    __syncthreads();
    if (F.tid < 32) { int n = (int)__hip_atomic_load(F.ctl + CW_CNT + 64 * F.tid, __ATOMIC_RELAXED, __HIP_MEMORY_SCOPE_AGENT); n = n < 0 ? 0 : (n > NTOK ? NTOK : n); cnt[F.tid] = n; }
    __syncthreads();
    if (F.tid == 0) { int s = 0; for (int e = 0; e < 32; ++e) { toff[e] = s; s += (cnt[e] + 255) >> 8; } toff[32] = s; }
    __syncthreads();
    const int T = toff[32];
    if (F.tid < MAXU) { int v = -1; const int nwg = T * nN; const long L = (long)F.tid * F.G + F.bx;
        if (L < nwg) { int wgid = (int)L; { const int q = nwg / pg8::NXCD, r = nwg % pg8::NXCD, xcd = wgid % pg8::NXCD, off = wgid / pg8::NXCD; wgid = (xcd < r ? xcd * (q + 1) : r * (q + 1) + (xcd - r) * q) + off; }
            int e = 0; while (e < 31 && wgid >= toff[e + 1] * nN) ++e;
            const int loc = wgid - toff[e] * nN, ntl = toff[e + 1] - toff[e], pm = toff[e] + loc % ntl, pn = loc / ntl; v = pm | (pn << 12) | (e << 20); }
        utab[F.tid] = v; }
    __syncthreads();
    return T;
}
struct SchedMoe { unsigned a, bt; const LAS int* utab; const LAS int* toff; int nN; bool gather; int r0, nr;
    __device__ __forceinline__ bool next(int i_, pg8::Unit& u) const { const int i = r0 + i_; u.pm = 0; u.pn = 0; u.aux = 0; if (i_ >= nr || i >= MAXU) return false; const int v = __builtin_amdgcn_readfirstlane(utab[i]); if (v < 0) return false; u.pm = v & 4095; u.pn = (v >> 12) & 255; u.aux = v >> 20; return true; }
    __device__ __forceinline__ unsigned abase(const pg8::Unit& u) const { return gather ? a : a + (unsigned)u.pm * (256u * DM); }
    __device__ __forceinline__ unsigned bbase(const pg8::Unit& u) const { return bt + ((unsigned)u.aux * (unsigned)nN + (unsigned)u.pn) * (256u * DM); } };
struct EpiMoe1 { unsigned char* act; const float* b1;
    __device__ __forceinline__ void operator()(const f32x4 (&acc)[2][2][4][2], const pg8::Unit& u, int wr, int wc, int fr_, int fq_) const {
        const int ln_ = get_lane(); const int fr = ln_ & 15, fq = ln_ >> 4; (void)fr_; (void)fq_;
        const int row0 = u.pm * 256 + wr * 64 + fr, ch0 = 128 * u.pn + 32 * wc + 8 * fq; const float* bp = b1 + (size_t)u.aux * 2 * DFF + ch0;
        const f32x4 bg0 = *(const f32x4*)bp, bg1 = *(const f32x4*)(bp + 4), bl0 = *(const f32x4*)(bp + DFF), bl1 = *(const f32x4*)(bp + DFF + 4);
#pragma unroll
        for (int ai = 0; ai < 2; ++ai)
#pragma unroll
            for (int m = 0; m < 4; ++m) { const int row = row0 + ai * 128 + m * 16; float o[8];
#pragma unroll
                for (int n = 0; n < 2; ++n)
#pragma unroll
                    for (int ip = 0; ip < 2; ++ip) {
                        const f32x4 ag = acc[ai][0][m][n], al = acc[ai][1][m][n], bgv = n ? bg1 : bg0, blv = n ? bl1 : bl0;
                        const f32x2 a2 = {ag[2 * ip], ag[2 * ip + 1]}, l2 = {al[2 * ip], al[2 * ip + 1]}, bg2 = {bgv[2 * ip], bgv[2 * ip + 1]}, bl2 = {blv[2 * ip], blv[2 * ip + 1]};
                        f32x2 gl = a2 * FP8_DESCALE + bg2, li = l2 * FP8_DESCALE + bl2;
                        gl[0] = fminf(gl[0], 7.0f); gl[1] = fminf(gl[1], 7.0f); li[0] = fminf(fmaxf(li[0], -7.0f), 7.0f); li[1] = fminf(fmaxf(li[1], -7.0f), 7.0f);
                        const f32x2 xe = gl * (-1.702f * 1.4426950408889634f); f32x2 ee = {__builtin_amdgcn_exp2f(xe[0]), __builtin_amdgcn_exp2f(xe[1])}; ee = ee + 1.0f;
                        const f32x2 sg = {__builtin_amdgcn_rcpf(ee[0]), __builtin_amdgcn_rcpf(ee[1])};
                        const f32x2 ov = (gl * sg) * (li * FP8_AS + FP8_AS);
                        o[4 * n + 2 * ip] = ov[0]; o[4 * n + 2 * ip + 1] = ov[1]; }
                u32x2 w; w.x = cvt4_fp8(o[0], o[1], o[2], o[3]); w.y = cvt4_fp8(o[4], o[5], o[6], o[7]);
                *(u32x2*)(act + (unsigned)(row * DFF + ch0)) = w; } } };
constexpr float Y2_S = 32.0f;
struct EpiMoe2 { unsigned char* y2; const float* b2;
    __device__ __forceinline__ void operator()(const f32x4 (&acc)[2][2][4][2], const pg8::Unit& u, int wr, int wc, int fr_, int fq_) const {
        const int ln_ = get_lane(); const int fr = ln_ & 15, fq = ln_ >> 4; (void)fr_; (void)fq_;
        const int row0 = u.pm * 256 + wr * 64 + fr, col0 = 256 * u.pn + 32 * wc + 8 * fq; const float* bp = b2 + (size_t)u.aux * DM + col0;
        f32x4 bv[2][2];
#pragma unroll
        for (int bj = 0; bj < 2; ++bj) { bv[bj][0] = *(const f32x4*)(bp + 128 * bj) * Y2_S; bv[bj][1] = *(const f32x4*)(bp + 128 * bj + 4) * Y2_S; }
#pragma unroll
        for (int ai = 0; ai < 2; ++ai)
#pragma unroll
            for (int m = 0; m < 4; ++m) { const int row = row0 + ai * 128 + m * 16;
#pragma unroll
                for (int bj = 0; bj < 2; ++bj) { const f32x4 a = acc[ai][bj][m][0] * (FP8_DESCALE * Y2_S) + bv[bj][0], b = acc[ai][bj][m][1] * (FP8_DESCALE * Y2_S) + bv[bj][1];
                    u32x2 w; w.x = cvt4_fp8(a[0], a[1], a[2], a[3]); w.y = cvt4_fp8(b[0], b[1], b[2], b[3]);
                    *(u32x2*)(y2 + (unsigned)(row * DM + col0 + 128 * bj)) = w; } } } };

__device__ __forceinline__ void p9_final(const Frame& F, const Args& A) {
    LAS int* toff = (LAS int*)(F.lds + MISC_OFF + 64);
    (void)moe_tables(F, 8);
    const float* mod = (const float*)(F.ws + WS_MOD); const bf16_t* x1p = (const bf16_t*)(F.ws + WS_X1); const unsigned char* y2 = F.ws + WS_Y2;
    const int* toke = (const int*)(F.ws + WS_TOKE); const float* tokg = (const float*)(F.ws + WS_TOKG); const int* toks = (const int*)(F.ws + WS_TOKS);
    const int lane = F.lane;
    LAS float* PWL = (LAS float*)F.lds; LAS float* G2L = PWL + DM;
    static_assert((1 + NTOK / SEQ) * DM * 4 <= RING_BYTES && DM == 4 * 512, "P9 LDS");
    { *(LAS f32x4*)(PWL + 4 * F.tid) = *(const f32x4*)(ldp(F, I_POST_FFN) + 4 * F.tid);
#pragma unroll
      for (int bb = 0; bb < NTOK / SEQ; ++bb) *(LAS f32x4*)(G2L + bb * DM + 4 * F.tid) = *(const f32x4*)(mod + (size_t)bb * (6 * DM) + 5 * DM + 4 * F.tid); }
    __syncthreads();
    for (int row = F.bx * 8 + F.wave; row < NTOK; row += F.G * 8) {
        const float* mrow = mod + (size_t)(row / SEQ) * (6 * DM);
        f32x4 mo[8];
#pragma unroll
        for (int j = 0; j < 8; ++j) mo[j] = (f32x4){0.f, 0.f, 0.f, 0.f};
#pragma unroll
        for (int k = 0; k < 4; ++k) { const int e = toke[row * 4 + k]; const float gt = tokg[row * 4 + k]; const size_t r = (size_t)toff[e] * 256 + toks[row * 4 + k];
            const unsigned char* yp = y2 + r * DM + 4 * lane; const float gs = gt * (1.0f / Y2_S);
#pragma unroll
            for (int j = 0; j < 8; ++j) { const unsigned v = __builtin_nontemporal_load((const unsigned*)(yp + 256 * j));
                const auto lo = __builtin_amdgcn_cvt_pk_f32_fp8((int)v, false), hi = __builtin_amdgcn_cvt_pk_f32_fp8((int)v, true);
                mo[j][0] += gs * lo[0]; mo[j][1] += gs * lo[1]; mo[j][2] += gs * hi[0]; mo[j][3] += gs * hi[1]; } }
        float ss = 0.f;
#pragma unroll
        for (int j = 0; j < 8; ++j) ss += mo[j][0] * mo[j][0] + mo[j][1] * mo[j][1] + mo[j][2] * mo[j][2] + mo[j][3] * mo[j][3];
        const float rstd = rsqrtf(wave_sum(ss) * (1.0f / DM) + EPS);
#pragma unroll
        for (int j = 0; j < 8; ++j) { const int col = 4 * lane + 256 * j; const u32x2 xb = __builtin_nontemporal_load((const u32x2*)(x1p + (size_t)row * DM + col)); const f32x4 xv = (f32x4){bf_lo(xb.x), bf_hi(xb.x), bf_lo(xb.y), bf_hi(xb.y)}, pw = *(const LAS f32x4*)(PWL + col), g2 = *(const LAS f32x4*)(G2L + (row / SEQ) * DM + col);
            f32x4 o;
#pragma unroll
            for (int i = 0; i < 4; ++i) o[i] = xv[i] + g2[i] * (mo[j][i] * rstd * pw[i]);
            __builtin_nontemporal_store(o, (f32x4*)(ldp_out(F) + (size_t)row * DM + col)); }
    }
}

__global__ void __launch_bounds__(512, 2) fwd_kernel(Args args) {
    extern __shared__ __attribute__((aligned(16))) unsigned char lds_raw[];
    Frame F;
    F.lds = (LAS unsigned char*)lds_raw; F.wave = __builtin_amdgcn_readfirstlane((int)threadIdx.x >> 6); F.lane = get_lane(); F.tid = F.wave * 64 + F.lane; F.G = gridDim.x; F.bx = blockIdx.x;
    F.ws = args.ws; F.ctl = (unsigned*)(args.ws + WS_CTL);
    const Args& A = args;
    volatile LAS unsigned* MISC = (volatile LAS unsigned*)(F.lds + MISC_OFF);
    if (F.tid == 0) { LAS unsigned long long* pt = (LAS unsigned long long*)(F.lds + PTAB_OFF);
#pragma unroll
        for (int k = 0; k < 25; ++k) pt[k] = (unsigned long long)args.in[k];
        pt[25] = (unsigned long long)args.out; }
    if (F.tid < 4) MISC[F.tid] = 0u;
    __syncthreads();
#if N_LAUNCH_MODE == 1
    constexpr int lo = 0, hi = NPHASE; constexpr bool one = true;
#else
    const int lo = args.ph_lo, hi = args.ph_hi;
    const bool one = (hi - lo) > 1;
#endif
    XcdBarrier bar; bar.bar = F.ctl + CW_BAR; bar.x = 0; bar.st = MISC; bar.w0 = 0;
    if (one) bar = xcd_barrier_post(F.ctl + CW_BAR, MISC);
    bar.w0 = (F.wave == 0) ? 1 : 0;
#define IN(k) (lo <= (k) && (k) < hi)
#define REFRESH() do { F.lane = get_lane(); F.tid = F.wave * 64 + F.lane; } while (0)
#define SEAM(k) do { if (IN(k) && IN((k) + 1)) xcd_barrier(bar); } while (0)

    if (IN(0)) { REFRESH(); p0_prologue(F, A); } SEAM(0);
    if (IN(1)) { REFRESH(); p1_norm_mod(F, A); } SEAM(1);
    if (IN(2)) { REFRESH();
        const bool even = (F.G == 256);
        const int ntc = (F.bx < 64) ? 23 : 35, tb = (F.bx < 64) ? 23 * F.bx : 64 * 23 + (F.bx - 64) * 35;
        EpiIn E{F.ws};
        const int grp = (F.bx >> 3) & 3;
        EpiGlu8 E8{F.ws};
#pragma unroll 1
        for (int seg = 0; seg < 4; ++seg) {
            if (even && grp == seg) { REFRESH(); cvt_tiles_tp<true>(F, A, tb, 1, tb + ntc); REFRESH(); }
            if (seg == 2) { SchedIn S{F.G, F.bx, 0, 2, true}; pg8::gemm_phase<EpiGlu8, SchedIn, false, true, false>(F.lds, F.ws, F.wave, DM, S, E8, nullptr); }
            else { SchedIn S{F.G, F.bx, seg == 3 ? 4 : 2 * seg, seg == 3 ? (1 << 20) : 2, false}; pg8::gemm_phase<EpiIn, SchedIn, false, false>(F.lds, F.ws, F.wave, DM * 2, S, E, nullptr); }
        }
        if (!even) cvt_tiles<true>(F, A, F.bx, F.G, NE * 256 + NE * 128);
    } SEAM(2);
    if (IN(3)) { REFRESH(); for (int u = F.bx; u < 256; u += F.G) p3_state_unit(F, A, u); for (int u = F.bx; u < 256; u += F.G) p3_conv_unit(F, A, u); } SEAM(3);
    if (IN(4)) { REFRESH(); p4_retention(F, A); } SEAM(4);
    if (IN(5)) { REFRESH(); EpiBf16 E{(bf16_t*)(F.ws + WS_MIX), DM, FP8_DESCALE};
        SchedDense S{(unsigned)WS_Y, (unsigned)WS_WOUT, 64, 8, F.G, F.bx, (unsigned)DM, 0, 1 << 20}; pg8::gemm_phase<EpiBf16, SchedDense, false, true, false>(F.lds, F.ws, F.wave, DM, S, E, nullptr);
    } SEAM(5);
    if (IN(6)) { REFRESH(); p6_mid(F, A); } SEAM(6);
    if (IN(7)) { REFRESH();
        (void)moe_tables(F, 16);
        const LAS int* utab = (const LAS int*)(F.lds + MISC_OFF + 512); const LAS int* toff = (const LAS int*)(F.lds + MISC_OFF + 64); const LAS int* cnt = (const LAS int*)(F.lds + MISC_OFF + 256);
        LAS unsigned* gtab = (LAS unsigned*)(F.lds + GTAB_OFF); const int* list = (const int*)(F.ws + WS_LIST);
        for (int idx = F.tid; idx < MAXU * 256; idx += 512) { const int i = idx >> 8, r = idx & 255, v = utab[i]; unsigned off = 0u;
            if (v >= 0) { const int pm = v & 4095, e = v >> 20, slot = (pm - toff[e]) * 256 + r; const int tok = (slot < cnt[e]) ? list[e * NTOK + slot] : 0; off = (unsigned)tok * (unsigned)DM; }
            gtab[idx] = off; }
        __syncthreads();
        EpiMoe1 E{F.ws + WS_ACT, ldp(F, I_B1)};
        const bool even = (F.G == 256); const int tb = 8192 + 16 * F.bx;
        const int grp = (F.bx & 7) % 3;
        if (even && grp == 0) { cvt_tiles_tp<true>(F, A, tb, 1, tb + 16); REFRESH(); }
        { SchedMoe S{(unsigned)WS_H2, (unsigned)WS_W1, utab, toff, 16, true, 0, 9}; pg8::gemm_phase<EpiMoe1, SchedMoe, true, true, false>(F.lds, F.ws, F.wave, DM, S, E, gtab); }
        if (even && grp == 1) { REFRESH(); cvt_tiles_tp<true>(F, A, tb, 1, tb + 16); REFRESH(); }
        { SchedMoe S{(unsigned)WS_H2, (unsigned)WS_W1, utab, toff, 16, true, 9, 1 << 20}; pg8::gemm_phase<EpiMoe1, SchedMoe, true, true, false>(F.lds, F.ws, F.wave, DM, S, E, gtab + 9 * 256); }
        if (even && grp == 2) { REFRESH(); cvt_tiles_tp<true>(F, A, tb, 1, tb + 16); }
    } SEAM(7);
    if (IN(8)) { REFRESH();
        (void)moe_tables(F, 8);
        const LAS int* utab = (const LAS int*)(F.lds + MISC_OFF + 512); const LAS int* toff = (const LAS int*)(F.lds + MISC_OFF + 64);
        SchedMoe S{(unsigned)WS_ACT, (unsigned)WS_W2, utab, toff, 8, false, 0, 1 << 20}; EpiMoe2 E{F.ws + WS_Y2, ldp(F, I_B2)};
        pg8::gemm_phase<EpiMoe2, SchedMoe, false, true, false>(F.lds, F.ws, F.wave, DFF, S, E, nullptr); } SEAM(8);
    if (IN(9)) { REFRESH(); p9_final(F, A); }
#undef IN
#undef SEAM
}

extern "C" void kernel_launch(void* const* d_in, const int* in_sizes, int n_in, void* d_out, int out_size, void* d_ws, size_t ws_size, hipStream_t stream) {
    static int grid = 0;
    if (grid == 0) {
        if (n_in != 25 || ws_size < WS_END) { fprintf(stderr, "kernel_launch: unexpected n_in %d or workspace %zu < %zu\n", n_in, ws_size, (size_t)WS_END); grid = -1; return; }
        int dev = 0, cus = 0, per_cu = 0;
        if (hipGetDevice(&dev) != hipSuccess || hipDeviceGetAttribute(&cus, hipDeviceAttributeMultiprocessorCount, dev) != hipSuccess) { grid = -1; return; }
        if (hipFuncSetAttribute((const void*)fwd_kernel, hipFuncAttributeMaxDynamicSharedMemorySize, LDS_BYTES) != hipSuccess) { fprintf(stderr, "kernel_launch: hipFuncSetAttribute failed\n"); grid = -1; return; }
        if (hipOccupancyMaxActiveBlocksPerMultiprocessor(&per_cu, (const void*)fwd_kernel, 512, LDS_BYTES) != hipSuccess || per_cu < 1) { fprintf(stderr, "kernel_launch: occupancy query says %d\n", per_cu); }
        (void)hipGetLastError();
        grid = cus;
    }
    if (grid < 0) return;
    (void)hipMemsetAsync((char*)d_ws + WS_CTL, 0, CTL_ZERO_BYTES, stream);
    Args a{};
    for (int i = 0; i < 25; ++i) a.in[i] = (const float*)d_in[i];
    a.out = (float*)d_out; a.ws = (unsigned char*)d_ws;
#if N_LAUNCH_MODE == 1
    a.ph_lo = 0; a.ph_hi = NPHASE;
    hipLaunchKernelGGL(fwd_kernel, dim3(grid), dim3(512), LDS_BYTES, stream, a);
#else
    for (int p = 0; p < NPHASE; ++p) { a.ph_lo = p; a.ph_hi = p + 1; hipLaunchKernelGGL(fwd_kernel, dim3(grid), dim3(512), LDS_BYTES, stream, a); }
#endif
}
```

```cpp
#include <hip/hip_runtime.h>
#include <cstdio>
#include <cstdint>

#ifndef N_LAUNCH_MODE
#define N_LAUNCH_MODE 1
#endif

#define LAS __attribute__((address_space(3)))
typedef unsigned short bf16_t;
typedef short bf16x8 __attribute__((ext_vector_type(8)));
typedef short s16x4 __attribute__((ext_vector_type(4)));
typedef float f32x4 __attribute__((ext_vector_type(4)));
typedef float f32x2 __attribute__((ext_vector_type(2)));
typedef unsigned u32x4 __attribute__((ext_vector_type(4)));
typedef unsigned u32x2 __attribute__((ext_vector_type(2)));
typedef int i32x4 __attribute__((ext_vector_type(4)));
typedef int i32x8 __attribute__((ext_vector_type(8)));
typedef int i32x16 __attribute__((ext_vector_type(16)));
typedef int i32x32 __attribute__((ext_vector_type(32)));

constexpr int NB = 8, SEQ = 2048, DM = 2048, NTOK = NB * SEQ, CTXL = 256, NCTX = NB * CTXL;
constexpr int NH = 8, HD = 128, DRET = 1024, DCONV = 1024, DIN = 6144, CONVW = 31, CONVP = 15, CHUNK = 128, NCHUNK = SEQ / CHUNK;
constexpr int NE = 32, TOPK = 4, DFF = 2048, GRIDW = 64;
constexpr float EPS = 1e-6f, GN_EPS = 1e-5f;
constexpr int MAXTILES = NTOK * TOPK / 256 + NE;
constexpr int NPHASE = 10;

constexpr size_t MiB = 1u << 20;
constexpr size_t WS_CTL = 0, CTL_ZERO_BYTES = 65536;
constexpr size_t WS_MOD = 1 * MiB;
constexpr size_t WS_RWT = 2 * MiB;
constexpr size_t WS_WIN = 4 * MiB;
constexpr size_t WS_WOUT = 28 * MiB;
constexpr size_t WS_W1 = 36 * MiB;
constexpr size_t WS_W2 = 548 * MiB;
constexpr size_t WS_HLAT = 804 * MiB;
constexpr size_t WS_HCTX = 868 * MiB;
constexpr size_t WS_Q = 876 * MiB, WS_K = 908 * MiB, WS_V = 940 * MiB, WS_G = 972 * MiB, WS_U = 1004 * MiB;
constexpr size_t WS_KC = 1036 * MiB, WS_VC = 1040 * MiB;
constexpr size_t WS_SF = 1044 * MiB, WS_SB = 1076 * MiB;
constexpr size_t WS_Y = 1108 * MiB;
constexpr size_t WS_MIX = 1172 * MiB;
constexpr size_t WS_X1 = 1300 * MiB;
constexpr size_t WS_H2 = 1428 * MiB;
constexpr size_t WS_TOKE = 1492 * MiB, WS_TOKG = 1493 * MiB, WS_TOKS = 1494 * MiB;
constexpr size_t WS_LIST = 1495 * MiB;
constexpr size_t WS_ACT = 1497 * MiB;
constexpr size_t WS_Y2 = 1785 * MiB;
constexpr size_t WS_H8 = 2073 * MiB;
constexpr size_t WS_WIN8 = 2105 * MiB;
constexpr size_t WS_END = 2111 * MiB;
constexpr int CW_TMO = 0, CW_BAR = 4096, CW_CNT = 8192;

constexpr int RING_BYTES = 139264;
constexpr int MISC_OFF = RING_BYTES;
constexpr int PTAB_OFF = MISC_OFF + 640;
constexpr int GTAB_OFF = MISC_OFF + 1024;
constexpr int MAXU = 20;
constexpr int LDS_BYTES = GTAB_OFF + MAXU * 1024;
static_assert(LDS_BYTES <= 163840, "LDS");

__device__ __forceinline__ unsigned cvt_pk_bf16(float lo, float hi) { unsigned r; asm("v_cvt_pk_bf16_f32 %0, %1, %2" : "=v"(r) : "v"(lo), "v"(hi)); return r; }
__device__ __forceinline__ float bf_lo(unsigned u) { return __uint_as_float(u << 16); }
__device__ __forceinline__ float bf_hi(unsigned u) { return __uint_as_float(u & 0xffff0000u); }
__device__ __forceinline__ float bf1(bf16_t b) { return __uint_as_float(((unsigned)b) << 16); }
__device__ __forceinline__ float wave_sum(float v) {
#pragma unroll
    for (int o = 32; o >= 1; o >>= 1) v += __shfl_xor(v, o);
    return v; }
__device__ __forceinline__ float sigmoidf_(float x) { return __builtin_amdgcn_rcpf(1.0f + __expf(-x)); }
__device__ __forceinline__ float siluf_(float x) { return x * sigmoidf_(x); }
__device__ __forceinline__ float log_sigmoid_(float x) { return fminf(x, 0.f) - log1pf(__expf(-fabsf(x))); }
constexpr float FP8_AS = 4.0f, FP8_BS = 64.0f, FP8_DESCALE = 1.0f / (FP8_AS * FP8_BS);
__device__ __forceinline__ unsigned cvt4_fp8(float a, float b, float c, float d) { int p = __builtin_amdgcn_cvt_pk_fp8_f32(a, b, 0, false); p = __builtin_amdgcn_cvt_pk_fp8_f32(c, d, p, true); return (unsigned)p; }
__device__ __forceinline__ int get_lane() { int l; asm volatile("v_mbcnt_lo_u32_b32 %0, -1, 0\n\tv_mbcnt_hi_u32_b32 %0, -1, %0" : "=v"(l)); return l; }
__host__ __device__ __forceinline__ int slot128(int r) { return 32 * (r >> 5) + 16 * ((r >> 2) & 1) + 4 * ((r >> 3) & 3) + (r & 3); }

#define XB_TMO      128
#define XB_XCNT(j)  (256  + 64 * (j))
#define XB_XSUB(j)  (1280 + 64 * (j))
#define XB_XGEN(j)  (2304 + 64 * (j))
#define XB_TOP      3328
#define XB_TOPGEN   3392
#define XCD_BAR_WORDS 3456
#define XB_SPIN_CAP (1u << 18)

__device__ __forceinline__ unsigned xb_ld(unsigned* p)              { return __hip_atomic_load(p, __ATOMIC_RELAXED, __HIP_MEMORY_SCOPE_AGENT); }
__device__ __forceinline__ unsigned xb_add(unsigned* p, unsigned v) { return __hip_atomic_fetch_add(p, v, __ATOMIC_RELAXED, __HIP_MEMORY_SCOPE_AGENT); }
__device__ __forceinline__ unsigned xb_xcc_id() { return (unsigned)__builtin_amdgcn_s_getreg((3 << 11) | 20) & 0xFu; }
#define XB_SPIN(cond, bar) do { unsigned _sp = 0; while (cond) { __builtin_amdgcn_s_sleep(1); \
    if ((++_sp & 255u) == 0u) { if (xb_ld(&(bar)[XB_TMO])) break; if (_sp > XB_SPIN_CAP) { atomicAdd(&(bar)[XB_TMO], 1u); break; } } } } while (0)

struct XcdBarrier { unsigned* bar; unsigned x; volatile LAS unsigned* st; int w0; };

__device__ __forceinline__ XcdBarrier xcd_barrier_post(unsigned* bar, volatile LAS unsigned* st) {
    XcdBarrier b; b.bar = bar; b.x = xb_xcc_id(); b.st = st; b.w0 = 0;
    if (threadIdx.x == 0) (void)xb_add(&bar[XB_XCNT(b.x)], 1u);
    return b;
}
__device__ __forceinline__ void xcd_barrier_complete(unsigned* bar, unsigned x, unsigned& nloc, unsigned& nx) {
    const unsigned G = gridDim.x * gridDim.y * gridDim.z;
    unsigned sum, cnt, mine, sp = 0u;
    for (;;) {
        sum = 0u; cnt = 0u; mine = 0u;
#pragma unroll
        for (unsigned j = 0; j < 16; ++j) { const unsigned c = xb_ld(&bar[XB_XCNT(j)]); sum += c; cnt += (c > 0u) ? 1u : 0u; mine = (j == x) ? c : mine; }
        if (sum == G) break;
        __builtin_amdgcn_s_sleep(1);
        if ((++sp & 255u) == 0u) { if (xb_ld(&bar[XB_TMO])) break; if (sp > XB_SPIN_CAP) { atomicAdd(&bar[XB_TMO], 1u); break; } }
    }
    nloc = mine > 0u ? mine : 1u; nx = cnt > 0u ? cnt : 1u;
}
__device__ __forceinline__ void xcd_barrier(const XcdBarrier& b) {
    asm volatile("s_waitcnt vmcnt(0)" ::: "memory");
    __syncthreads();
    if (b.w0 && get_lane() == 0) {
        unsigned* bar = b.bar;
        __builtin_amdgcn_s_waitcnt(0);
        unsigned nloc = b.st[0], nx = b.st[1];
        if (nloc == 0u) { xcd_barrier_complete(bar, b.x, nloc, nx); b.st[0] = nloc; b.st[1] = nx; }
        const unsigned old = xb_add(&bar[XB_XSUB(b.x)], 1u);
        const unsigned gen = old / nloc;
        if (old + 1u == (gen + 1u) * nloc) {
            __builtin_amdgcn_fence(__ATOMIC_RELEASE, "agent");
            asm volatile("s_waitcnt vmcnt(0)" ::: "memory");
            const unsigned og = xb_add(&bar[XB_TOP], 1u);
            const unsigned tg = og / nx;
            if (og + 1u == (tg + 1u) * nx) xb_add(&bar[XB_TOPGEN], 1u);
            else XB_SPIN(xb_ld(&bar[XB_TOPGEN]) == tg, bar);
            __builtin_amdgcn_fence(__ATOMIC_ACQUIRE, "agent");
            xb_add(&bar[XB_XGEN(b.x)], 1u);
            asm volatile("s_waitcnt vmcnt(0)" ::: "memory");
        } else {
            XB_SPIN(xb_ld(&bar[XB_XGEN(b.x)]) == gen, bar);
            __builtin_amdgcn_fence(__ATOMIC_ACQUIRE, "agent");
            asm volatile("s_waitcnt vmcnt(0)" ::: "memory");
        }
    }
    __syncthreads();
}

namespace pg8 {
constexpr int BM = 256, BK = 64, HALF = 128, HTB = HALF * BK * 2, STAGE_BYTES = 8 * HTB, NXCD = 8, WGM = 8;
__host__ __device__ __forceinline__ int lds_byte(int r, int c) { const int st = (r >> 4) * 2 + (c >> 5), rr = r & 15, cc = c & 31, ob = rr * 64 + cc * 2; return st * 1024 + (ob ^ (((ob >> 9) & 1) << 5)); }
__host__ __device__ __forceinline__ void stage_rc(int b, int& R, int& C) { const int st = b / 1024, sb = b % 1024, swz = sb ^ (((sb >> 9) & 1) << 5); R = (st >> 1) * 16 + swz / 64; C = (st & 1) * 32 + (swz % 64) / 2; }

struct Unit { int pm, pn, aux; };
__device__ __forceinline__ unsigned vadd_opaque(unsigned a, unsigned k) { unsigned r; asm volatile("v_add_u32 %0, %1, %2" : "=v"(r) : "v"(a), "s"(k)); return r; }
__device__ __forceinline__ i32x8 cat8(bf16x8 lo, bf16x8 hi) { const i32x4 a = (i32x4)lo, b = (i32x4)hi; return __builtin_shufflevector(a, b, 0, 1, 2, 3, 4, 5, 6, 7); }
__device__ __forceinline__ bf16x8 lo8(i32x8 v) { return (bf16x8)__builtin_shufflevector(v, v, 0, 1, 2, 3); }
__device__ __forceinline__ bf16x8 hi8(i32x8 v) { return (bf16x8)__builtin_shufflevector(v, v, 4, 5, 6, 7); }
__device__ __forceinline__ bool static_order(int nM, int nN, int G, int c, int i, int& pm, int& pn) {
    const int nwg = nM * nN; const long L = (long)i * G + c; if (L >= nwg) return false;
    int wgid = (int)L; { const int q = nwg / NXCD, r = nwg % NXCD, xcd = wgid % NXCD, off = wgid / NXCD; wgid = (xcd < r ? xcd * (q + 1) : r * (q + 1) + (xcd - r) * q) + off; }
    const int nig = WGM * nN, gid = wgid / nig, fm = gid * WGM, gsz = (nM - fm) < WGM ? (nM - fm) : WGM;
    pm = fm + ((wgid % nig) % gsz); pn = (wgid % nig) / gsz; return true;
}

template <class Epi, class Sched, bool GATHER, bool FP8, bool SPLIT = FP8>
__device__ __forceinline__ void gemm_phase(LAS unsigned char* lds, unsigned char* wsbase, const int wid, const int RB, const Sched& S, const Epi& E, const LAS unsigned* gtab) {
    const int lane = get_lane(), tid = wid * 64 + lane, wr = wid >> 2, wc = wid & 3, fr = lane & 15, fq = lane >> 4;
    const int nt = RB / 128;
    const __amdgpu_buffer_rsrc_t rs = __builtin_amdgcn_make_buffer_rsrc((void*)wsbase, 0, -1, 0x00020000);
    unsigned voff0; int rowA0;
    { int R, C; stage_rc(tid * 16, R, C); voff0 = (unsigned)(R * RB + C * 2); rowA0 = R; }
#define PG8_VOFF(i_) ((i_) == 0 ? voff0 : vadd_opaque(voff0, 64u * (unsigned)RB))
#define PG8_ROWA(i_) ((i_) == 0 ? rowA0 : (int)vadd_opaque((unsigned)rowA0, 64u))
    const unsigned kstep = 128u;
    const unsigned hstep = (unsigned)HALF * (unsigned)RB;
    const unsigned ahstep = GATHER ? 0u : hstep;
    const unsigned ldsw = (unsigned)wid * 1024u;
    const int aoff = lds_byte(wr * 64 + fr, fq * 8), boff = lds_byte(wc * 32 + fr, fq * 8);
#define PG8_SA(b, h) (((b) * 2 + (h)) * HTB)
#define PG8_SB(b, h) ((4 + (b) * 2 + (h)) * HTB)
#define PG8_STAGE_B(bufoff, soff) do { _Pragma("unroll") for (int _i = 0; _i < 2; ++_i) \
        __builtin_amdgcn_raw_ptr_buffer_load_lds(rs, (LAS void*)(lds + (bufoff) + ldsw + _i * 8192), 16, PG8_VOFF(_i), (soff), 0, 0); } while (0)
#define PG8_GOFF(h, uidx) do { if constexpr (GATHER) { _Pragma("unroll") for (int _i = 0; _i < 2; ++_i) go[_i] = gtab[(uidx) * 256 + (h) * 128 + PG8_ROWA(_i)] + (voff0 - (unsigned)(rowA0 * RB)); } } while (0)
#define PG8_STAGE_A(bufoff, soff, h) do { _Pragma("unroll") for (int _i = 0; _i < 2; ++_i) \
        __builtin_amdgcn_raw_ptr_buffer_load_lds(rs, (LAS void*)(lds + (bufoff) + ldsw + _i * 8192), 16, GATHER ? go[_i] : PG8_VOFF(_i), (soff) + (unsigned)(h) * ahstep, 0, 0); } while (0)
#define PG8_LD8(addr) cat8(*(const LAS bf16x8*)(addr), *(const LAS bf16x8*)((addr) + 1024))
#define PG8_LDA(dst, b, h) do { _Pragma("unroll") for (int m = 0; m < 4; ++m) dst[m] = PG8_LD8(lds + PG8_SA(b, h) + aoff + m * 2048); } while (0)
#define PG8_LDA2(dst, b, h, m0) do { _Pragma("unroll") for (int m = 0; m < 2; ++m) dst[m] = PG8_LD8(lds + PG8_SA(b, h) + aoff + ((m0) + m) * 2048); } while (0)
#define PG8_LDB(dst, b, h) do { _Pragma("unroll") for (int n = 0; n < 2; ++n) dst[n] = PG8_LD8(lds + PG8_SB(b, h) + boff + n * 2048); } while (0)
#define PG8_MMA(ai, bj, At, Bt) do { __builtin_amdgcn_s_setprio(1); _Pragma("unroll") for (int m = 0; m < 4; ++m) _Pragma("unroll") for (int n = 0; n < 2; ++n) { \
        if constexpr (FP8) { acc[ai][bj][m][n] = __builtin_amdgcn_mfma_scale_f32_16x16x128_f8f6f4(Bt[n], At[m], acc[ai][bj][m][n], 0, 0, 0, 0x7F7F7F7F, 0, 0x7F7F7F7F); } \
        else { acc[ai][bj][m][n] = __builtin_amdgcn_mfma_f32_16x16x32_bf16(lo8(Bt[n]), lo8(At[m]), acc[ai][bj][m][n], 0, 0, 0); \
               acc[ai][bj][m][n] = __builtin_amdgcn_mfma_f32_16x16x32_bf16(hi8(Bt[n]), hi8(At[m]), acc[ai][bj][m][n], 0, 0, 0); } } \
        __builtin_amdgcn_s_setprio(0); } while (0)
#define PG8_MMA2(ai, At, m0) do { __builtin_amdgcn_s_setprio(1); _Pragma("unroll") for (int m = 0; m < 2; ++m) _Pragma("unroll") for (int n = 0; n < 2; ++n) { \
        acc[ai][0][(m0) + m][n] = __builtin_amdgcn_mfma_scale_f32_16x16x128_f8f6f4(B0[n], At[m], acc[ai][0][(m0) + m][n], 0, 0, 0, 0x7F7F7F7F, 0, 0x7F7F7F7F); \
        acc[ai][1][(m0) + m][n] = __builtin_amdgcn_mfma_scale_f32_16x16x128_f8f6f4(B1[n], At[m], acc[ai][1][(m0) + m][n], 0, 0, 0, 0x7F7F7F7F, 0, 0x7F7F7F7F); } \
        __builtin_amdgcn_s_setprio(0); } while (0)
#define PG8_WAIT_V(n) asm volatile("s_waitcnt vmcnt(" #n ")" ::: "memory")
#define PG8_WAIT_L(n) asm volatile("s_waitcnt lgkmcnt(" #n ")" ::: "memory")
#define PG8_BAR __builtin_amdgcn_s_barrier()
#define PG8_SCHED __builtin_amdgcn_sched_barrier(0)
    Unit cur, nxt; int ui = 0;
    if (!S.next(0, cur)) return;
    f32x4 acc[2][2][4][2];
#pragma unroll
    for (int a = 0; a < 2; ++a)
#pragma unroll
        for (int b = 0; b < 2; ++b)
#pragma unroll
            for (int m = 0; m < 4; ++m)
#pragma unroll
                for (int n = 0; n < 2; ++n) acc[a][b][m][n] = (f32x4){0.f, 0.f, 0.f, 0.f};
    i32x8 At[SPLIT ? 2 : 4], B0[2], B1[2];
    unsigned cA = S.abase(cur), cB = S.bbase(cur);
    unsigned go[2] = {0u, 0u};
    PG8_STAGE_B(PG8_SB(0, 0), cB); PG8_STAGE_B(PG8_SB(0, 1), cB + hstep); PG8_GOFF(0, 0); PG8_STAGE_A(PG8_SA(0, 0), cA, 0); PG8_GOFF(1, 0); PG8_STAGE_A(PG8_SA(0, 1), cA, 1);
    if (wr == 1) PG8_BAR;
    PG8_WAIT_V(2); PG8_BAR;
    PG8_STAGE_B(PG8_SB(1, 0), cB + kstep); PG8_GOFF(0, 0); PG8_STAGE_A(PG8_SA(1, 0), cA + kstep, 0); PG8_STAGE_B(PG8_SB(1, 1), cB + hstep + kstep);
    PG8_WAIT_V(6); PG8_BAR;
    for (;;) {
        const bool has_next = S.next(ui + 1, nxt);
        const unsigned nA = has_next ? S.abase(nxt) : cA, nB = has_next ? S.bbase(nxt) : cB;
        for (int t = 0; t < nt; t += 2) {
            const bool last = (t == nt - 2);
            const bool nx = last && has_next;
            const unsigned a1 = cA + (unsigned)(t + 1) * kstep;
            const unsigned a2 = last ? nA : cA + (unsigned)(t + 2) * kstep, b2 = last ? nB : cB + (unsigned)(t + 2) * kstep;
            const unsigned a3 = a2 + kstep, b3 = b2 + kstep;
            const int un = nx ? ui + 1 : ui;
            if constexpr (!SPLIT) {
            PG8_GOFF(1, ui); PG8_LDB(B0, 0, 0); PG8_LDB(B1, 0, 1); PG8_SCHED; PG8_LDA(At, 0, 0); PG8_STAGE_A(PG8_SA(1, 1), a1, 1);
            PG8_WAIT_V(8); PG8_WAIT_L(0); PG8_BAR; PG8_MMA(0, 0, At, B0); PG8_MMA(0, 1, At, B1); PG8_BAR; PG8_SCHED;
            PG8_GOFF(0, un); PG8_LDA(At, 0, 1); PG8_STAGE_B(PG8_SB(0, 0), b2); PG8_STAGE_B(PG8_SB(0, 1), b2 + hstep); PG8_STAGE_A(PG8_SA(0, 0), a2, 0);
            PG8_WAIT_V(8); PG8_WAIT_L(0); PG8_BAR; PG8_MMA(1, 0, At, B0); PG8_MMA(1, 1, At, B1); PG8_BAR; PG8_SCHED;
            PG8_GOFF(1, un); PG8_LDB(B0, 1, 0); PG8_LDB(B1, 1, 1); PG8_SCHED; PG8_LDA(At, 1, 0); PG8_STAGE_A(PG8_SA(0, 1), a2, 1);
            PG8_WAIT_V(8); PG8_WAIT_L(0); PG8_BAR; PG8_MMA(0, 0, At, B0); PG8_MMA(0, 1, At, B1); PG8_BAR; PG8_SCHED;
            PG8_GOFF(0, un); PG8_LDA(At, 1, 1); PG8_STAGE_B(PG8_SB(1, 0), b3); PG8_STAGE_B(PG8_SB(1, 1), b3 + hstep); PG8_STAGE_A(PG8_SA(1, 0), a3, 0);
            PG8_WAIT_V(8); PG8_WAIT_L(0); PG8_BAR; PG8_MMA(1, 0, At, B0); PG8_MMA(1, 1, At, B1); PG8_BAR; PG8_SCHED;
            } else {
            PG8_GOFF(1, ui); PG8_LDB(B0, 0, 0); PG8_LDB(B1, 0, 1); PG8_SCHED; PG8_LDA2(At, 0, 0, 0); PG8_STAGE_A(PG8_SA(1, 1), a1, 1);
            PG8_WAIT_V(8); PG8_WAIT_L(0); PG8_BAR; PG8_MMA2(0, At, 0); PG8_BAR; PG8_SCHED;
            PG8_LDA2(At, 0, 0, 2); PG8_WAIT_L(0); PG8_BAR; PG8_MMA2(0, At, 2); PG8_BAR; PG8_SCHED;
            PG8_GOFF(0, un); PG8_LDA2(At, 0, 1, 0); PG8_STAGE_B(PG8_SB(0, 0), b2); PG8_STAGE_B(PG8_SB(0, 1), b2 + hstep); PG8_STAGE_A(PG8_SA(0, 0), a2, 0);
            PG8_WAIT_V(8); PG8_WAIT_L(0); PG8_BAR; PG8_MMA2(1, At, 0); PG8_BAR; PG8_SCHED;
            PG8_LDA2(At, 0, 1, 2); PG8_WAIT_L(0); PG8_BAR; PG8_MMA2(1, At, 2); PG8_BAR; PG8_SCHED;
            PG8_GOFF(1, un); PG8_LDB(B0, 1, 0); PG8_LDB(B1, 1, 1); PG8_SCHED; PG8_LDA2(At, 1, 0, 0); PG8_STAGE_A(PG8_SA(0, 1), a2, 1);
            PG8_WAIT_V(8); PG8_WAIT_L(0); PG8_BAR; PG8_MMA2(0, At, 0); PG8_BAR; PG8_SCHED;
            PG8_LDA2(At, 1, 0, 2); PG8_WAIT_L(0); PG8_BAR; PG8_MMA2(0, At, 2); PG8_BAR; PG8_SCHED;
            PG8_GOFF(0, un); PG8_LDA2(At, 1, 1, 0); PG8_STAGE_B(PG8_SB(1, 0), b3); PG8_STAGE_B(PG8_SB(1, 1), b3 + hstep); PG8_STAGE_A(PG8_SA(1, 0), a3, 0);
            PG8_WAIT_V(8); PG8_WAIT_L(0); PG8_BAR; PG8_MMA2(1, At, 0); PG8_BAR; PG8_SCHED;
            PG8_LDA2(At, 1, 1, 2); PG8_WAIT_L(0); PG8_BAR; PG8_MMA2(1, At, 2); PG8_BAR; PG8_SCHED;
            }
        }
        if (wr == 0) PG8_BAR;
        E(acc, cur, wr, wc, fr, fq);
        if (!has_next) break;
#pragma unroll
        for (int a = 0; a < 2; ++a)
#pragma unroll
            for (int b = 0; b < 2; ++b)
#pragma unroll
                for (int m = 0; m < 4; ++m)
#pragma unroll
                    for (int n = 0; n < 2; ++n) acc[a][b][m][n] = (f32x4){0.f, 0.f, 0.f, 0.f};
        cur = nxt; cA = nA; cB = nB; ++ui;
        if (wr == 1) PG8_BAR;
    }
    PG8_WAIT_V(0);
    PG8_BAR;
#undef PG8_SA
#undef PG8_SB
#undef PG8_STAGE_A
#undef PG8_STAGE_B
#undef PG8_LDA
#undef PG8_LD8
#undef PG8_LDA2
#undef PG8_MMA2
#undef PG8_LDB
#undef PG8_MMA
#undef PG8_WAIT_V
#undef PG8_WAIT_L
#undef PG8_BAR
#undef PG8_SCHED
#undef PG8_GOFF
#undef PG8_VOFF
#undef PG8_ROWA
}
}

struct Args { const float* in[25]; float* out; unsigned char* ws; int ph_lo, ph_hi; };
struct Frame {
    LAS unsigned char* lds; int tid, lane, wave, G, bx;
    unsigned char* ws; unsigned* ctl;
};
enum { I_X = 0, I_C, I_CTX, I_C_CTX, I_ADA_W, I_ADA_B, I_PRE_MIX, I_POST_MIX, I_PRE_FFN, I_POST_FFN, I_W_IN, I_DEC_F, I_DEC_B, I_GN_W, I_CONV_W, I_CONV_B, I_LN_W, I_LN_B, I_W_OUT,
       I_ROUTER_W, I_ROUTER_B, I_W1, I_B1, I_W2, I_B2, I_OUT };
__device__ __forceinline__ const float* ldp(const Frame& F, int k) {
    const unsigned long long v = *(const LAS unsigned long long*)(F.lds + PTAB_OFF + 8 * k);
    const unsigned lo = __builtin_amdgcn_readfirstlane((unsigned)v), hi = __builtin_amdgcn_readfirstlane((unsigned)(v >> 32));
    return (const float*)(const __attribute__((address_space(1))) float*)(((unsigned long long)hi << 32) | lo); }
__device__ __forceinline__ float* ldp_out(const Frame& F) { return (float*)ldp(F, I_OUT); }

__device__ __forceinline__ int dest_row(int kind, int n) {
    if (kind == 0) return n;
    if (kind == 3) return (n & ~127) + slot128(n & 127);
    if (kind == 5) { const int c = n - 2048; return (c & ~127) + slot128(c & 127); }
    if (kind == 4) { const int c = n - 4096, ch = c & 1023, second = c >> 10; return 256 * (ch >> 7) + 128 * second + slot128(ch & 127); }
    if (kind == 2) { const int ch = n & 2047, second = n >> 11; return 256 * (ch >> 7) + 128 * second + slot128(ch & 127); }
    if (n < 2048) { const int base = n & ~1023, c = n & 1023, head = c >> 7, j = c & 127, pnl = head >> 1, bj = head & 1, nn = j >> 6, jj = j & 63;
        return base + 256 * pnl + 128 * bj + 32 * (jj >> 4) + 16 * nn + 4 * ((jj >> 2) & 3) + (jj & 3); }
    if (n < 4096) return (n & ~127) + slot128(n & 127);
    { const int c = n - 4096, ch = c & 1023, second = c >> 10; return 4096 + 256 * (ch >> 7) + 128 * second + slot128(ch & 127); }
}
struct CvtTile { const float* src; unsigned char* dst; int ldn, rowbytes, k0, n0, kind; };
template <bool FP8> __device__ __forceinline__ CvtTile cvt_decode(const Frame& F, const Args& A, int t) {
    CvtTile c;
    if constexpr (!FP8) {
        if (t < 32 * 16) { const int kt = t / 16, ntl = t % 16;                                  c.src = ldp(F, I_W_IN); c.dst = F.ws + WS_WIN; c.ldn = DIN; c.rowbytes = DM * 2; c.k0 = kt * 64; c.n0 = ntl * 256; c.kind = 1; }
        else { const int q = t - 32 * 16, kt = q / 8, ntl = q % 8; c.src = ldp(F, I_W_OUT); c.dst = F.ws + WS_WOUT; c.ldn = DM; c.rowbytes = DM * 2; c.k0 = kt * 64; c.n0 = ntl * 256; c.kind = 3; }
    } else {
        if (t < NE * 256) { const int e = t >> 8, r = t & 255, ntl = r >> 4, kt = r & 15;       c.src = ldp(F, I_W1) + (size_t)e * DM * 2 * DFF; c.dst = F.ws + WS_W1 + (size_t)e * 2 * DFF * DM; c.ldn = 2 * DFF; c.rowbytes = DM; c.k0 = kt * 128; c.n0 = ntl * 256; c.kind = 2; }
        else if (t < NE * 256 + NE * 128) { const int q = t - NE * 256, e = q >> 7, r = q & 127, ntl = r >> 4, kt = r & 15; c.src = ldp(F, I_W2) + (size_t)e * DFF * DM; c.dst = F.ws + WS_W2 + (size_t)e * DM * DFF; c.ldn = DM; c.rowbytes = DFF; c.k0 = kt * 128; c.n0 = ntl * 256; c.kind = 3; }
        else if (t < NE * 384 + 128) { const int q = t - NE * 384, ntl = q >> 4, kt = q & 15;      c.src = ldp(F, I_W_OUT); c.dst = F.ws + WS_WOUT; c.ldn = DM; c.rowbytes = DM; c.k0 = kt * 128; c.n0 = ntl * 256; c.kind = 3; }
        else if (t < NE * 384 + 256) { const int q = t - (NE * 384 + 128), ntl = q >> 4, kt = q & 15;     c.src = ldp(F, I_W_IN); c.dst = F.ws + WS_WIN8; c.ldn = DIN; c.rowbytes = DM; c.k0 = kt * 128; c.n0 = 4096 + ntl * 256; c.kind = 4; }
        else { const int q = t - (NE * 384 + 256), ntl = q >> 4, kt = q & 15;                      c.src = ldp(F, I_W_IN); c.dst = F.ws + WS_WIN8 + (size_t)8 * 256 * DM; c.ldn = DIN; c.rowbytes = DM; c.k0 = kt * 128; c.n0 = 2048 + ntl * 256; c.kind = 5; }
    }
    return c;
}
template <bool FP8> __device__ __forceinline__ void cvt_tiles(const Frame& F, const Args& A, int t0, int tstride, int tend) {
    constexpr int RPB = FP8 ? 16 : 8;
    LAS unsigned* T = (LAS unsigned*)F.lds;
    const int nq = F.tid & 63, kb = F.tid >> 6;
    f32x4 va[RPB], vb[RPB];
#define CVT_ISSUE(v, t_) do { if ((t_) < tend) { const CvtTile _c = cvt_decode<FP8>(F, A, (t_)); const float* _s = _c.src + (size_t)(_c.k0 + RPB * kb) * _c.ldn + _c.n0 + 4 * nq; \
        _Pragma("unroll") for (int r = 0; r < RPB; ++r) v[r] = __builtin_nontemporal_load((const f32x4*)(_s + (size_t)r * _c.ldn)); } } while (0)
#define CVT_PROCESS(v, t_, tnext_) do { const CvtTile _c = cvt_decode<FP8>(F, A, (t_)); \
        _Pragma("unroll") for (int g = 0; g < 4; ++g) _Pragma("unroll") for (int i = 0; i < 4; ++i) { unsigned u; \
            if constexpr (FP8) u = cvt4_fp8(v[4 * g][i] * FP8_BS, v[4 * g + 1][i] * FP8_BS, v[4 * g + 2][i] * FP8_BS, v[4 * g + 3][i] * FP8_BS); \
            else u = cvt_pk_bf16(v[2 * g][i], v[2 * g + 1][i]); \
            T[(4 * nq + i) * 33 + 4 * kb + g] = u; } \
        __syncthreads(); \
        CVT_ISSUE(v, (tnext_)); \
        { const int ch = F.tid & 7; \
        _Pragma("unroll") for (int j = 0; j < 4; ++j) { const int row = (F.tid >> 3) + 64 * j; \
            u32x4 o; o.x = T[row * 33 + 4 * ch]; o.y = T[row * 33 + 4 * ch + 1]; o.z = T[row * 33 + 4 * ch + 2]; o.w = T[row * 33 + 4 * ch + 3]; \
            const int drow = dest_row(_c.kind, _c.n0 + row); \
            u32x4* _p = (u32x4*)(_c.dst + (size_t)drow * _c.rowbytes + (size_t)_c.k0 * (FP8 ? 1 : 2) + 16 * ch); \
            if (_c.kind == 3 && FP8) *_p = o; else __builtin_nontemporal_store(o, _p); } } \
        __syncthreads(); } while (0)
    int t = t0; if (t >= tend) return;
    CVT_ISSUE(va, t); CVT_ISSUE(vb, t + tstride);
    for (;;) {
        CVT_PROCESS(va, t, t + 2 * tstride); t += tstride; if (t >= tend) break;
        CVT_PROCESS(vb, t, t + 2 * tstride); t += tstride; if (t >= tend) break;
    }
#undef CVT_ISSUE
#undef CVT_PROCESS
}
template <bool FP8> __device__ __forceinline__ void cvt_tiles_tp(const Frame& F, const Args& A, int t0, int tstride, int tend) {
    constexpr int RPB = FP8 ? 16 : 8;
    const int g = F.lane >> 3, j = F.lane & 7;
    f32x4 va[RPB], vb[RPB];
#define TP_ISSUE(v, t_) do { if ((t_) < tend) { const CvtTile _c = cvt_decode<FP8>(F, A, (t_)); const float* _s = _c.src + (size_t)(_c.k0 + RPB * g) * _c.ldn + _c.n0 + 32 * F.wave + 4 * j; \
        _Pragma("unroll") for (int r = 0; r < RPB; ++r) v[r] = __builtin_nontemporal_load((const f32x4*)(_s + (size_t)r * _c.ldn)); } } while (0)
#define TP_FINISH(v, t_) do { const CvtTile _c = cvt_decode<FP8>(F, A, (t_)); \
        _Pragma("unroll") for (int i = 0; i < 4; ++i) { u32x4 o; \
            if constexpr (FP8) { o.x = cvt4_fp8(v[0][i] * FP8_BS, v[1][i] * FP8_BS, v[2][i] * FP8_BS, v[3][i] * FP8_BS); o.y = cvt4_fp8(v[4][i] * FP8_BS, v[5][i] * FP8_BS, v[6][i] * FP8_BS, v[7][i] * FP8_BS); \
                o.z = cvt4_fp8(v[8 % RPB][i] * FP8_BS, v[9 % RPB][i] * FP8_BS, v[10 % RPB][i] * FP8_BS, v[11 % RPB][i] * FP8_BS); o.w = cvt4_fp8(v[12 % RPB][i] * FP8_BS, v[13 % RPB][i] * FP8_BS, v[14 % RPB][i] * FP8_BS, v[15 % RPB][i] * FP8_BS); } \
            else { o.x = cvt_pk_bf16(v[0][i], v[1][i]); o.y = cvt_pk_bf16(v[2][i], v[3][i]); o.z = cvt_pk_bf16(v[4][i], v[5][i]); o.w = cvt_pk_bf16(v[6][i], v[7][i]); } \
            const int drow = dest_row(_c.kind, _c.n0 + 32 * F.wave + 4 * j + i); \
            u32x4* _p = (u32x4*)(_c.dst + (size_t)drow * _c.rowbytes + (size_t)(_c.k0 + RPB * g) * (FP8 ? 1 : 2)); \
            if (_c.kind == 3 && FP8) *_p = o; else __builtin_nontemporal_store(o, _p); } } while (0)
    int t = t0; if (t >= tend) return;
    TP_ISSUE(va, t); TP_ISSUE(vb, t + tstride);
    for (;;) {
        TP_FINISH(va, t); TP_ISSUE(va, t + 2 * tstride); t += tstride; if (t >= tend) break;
        TP_FINISH(vb, t); TP_ISSUE(vb, t + 2 * tstride); t += tstride; if (t >= tend) break;
    }
#undef TP_ISSUE
#undef TP_FINISH
}
__device__ __forceinline__ void p0_prologue(const Frame& F, const Args& A) {
    constexpr int NADA = 6 * DM / 64;
    if (F.bx < NADA) {
        LAS float* tab = (LAS float*)F.lds;
        LAS float* red = (LAS float*)(F.lds + 98304);
        { const float* cp = ldp(F, I_C); const float* cc = ldp(F, I_C_CTX);
          float v[4][9];
#pragma unroll
          for (int j = 0; j < 4; ++j) { const int k = F.tid + 512 * j;
#pragma unroll
              for (int r = 0; r < 8; ++r) v[j][r] = cp[r * DM + k];
              v[j][8] = cc[k]; }
#pragma unroll
          for (int j = 0; j < 4; ++j) { const int k = F.tid + 512 * j;
              *(LAS f32x4*)(tab + k * 12) = (f32x4){siluf_(v[j][0]), siluf_(v[j][1]), siluf_(v[j][2]), siluf_(v[j][3])};
              *(LAS f32x4*)(tab + k * 12 + 4) = (f32x4){siluf_(v[j][4]), siluf_(v[j][5]), siluf_(v[j][6]), siluf_(v[j][7])};
              tab[k * 12 + 8] = siluf_(v[j][8]); } }
        __syncthreads();
        for (int u = F.bx; u < NADA; u += F.G) {
            const int col = u * 64 + F.lane; float acc[9];
#pragma unroll
            for (int r = 0; r < 9; ++r) acc[r] = 0.f;
            const float* wp = ldp(F, I_ADA_W) + (size_t)(F.wave * 256) * (6 * DM) + col;
            for (int k0 = 0; k0 < 256; k0 += 32) { float av[32];
#pragma unroll
                for (int j = 0; j < 32; ++j) av[j] = __builtin_nontemporal_load(wp + (size_t)(k0 + j) * (6 * DM));
#pragma unroll
                for (int j = 0; j < 32; ++j) { const float a = av[j]; const int k = F.wave * 256 + k0 + j;
                    const f32x4 s0 = *(const LAS f32x4*)(tab + k * 12), s1 = *(const LAS f32x4*)(tab + k * 12 + 4), s2 = *(const LAS f32x4*)(tab + k * 12 + 8);
                    acc[0] += a * s0[0]; acc[1] += a * s0[1]; acc[2] += a * s0[2]; acc[3] += a * s0[3]; acc[4] += a * s1[0]; acc[5] += a * s1[1]; acc[6] += a * s1[2]; acc[7] += a * s1[3]; acc[8] += a * s2[0]; } }
#pragma unroll
            for (int r = 0; r < 9; ++r) red[(F.wave * 9 + r) * 64 + F.lane] = acc[r];
            __syncthreads();
            for (int idx = F.tid; idx < 9 * 64; idx += 512) { const int r = idx >> 6, l = idx & 63; float s = 0.f;
#pragma unroll
                for (int w = 0; w < 8; ++w) s += red[(w * 9 + r) * 64 + l];
                ((float*)(F.ws + WS_MOD))[r * (6 * DM) + u * 64 + l] = s + ldp(F, I_ADA_B)[u * 64 + l]; }
            __syncthreads();
        }
    }
    for (int idx = F.bx * 512 + F.tid; idx < NE * DM; idx += F.G * 512) { const int e = idx / DM, k = idx % DM; ((bf16_t*)(F.ws + WS_RWT))[idx] = (bf16_t)(cvt_pk_bf16(ldp(F, I_ROUTER_W)[k * NE + e], 0.f) & 0xffffu); }
    if (F.G == 256) { if (F.bx < NADA) cvt_tiles_tp<false>(F, A, F.bx, NADA, F.bx < 128 ? 3 * NADA : 2 * NADA);
        else cvt_tiles_tp<true>(F, A, NE * 384 + (F.bx - NADA), 256 - NADA, NE * 384 + 320); }
    else { cvt_tiles<false>(F, A, F.bx, F.G, 32 * 16); cvt_tiles<true>(F, A, NE * 384 + F.bx, F.G, NE * 384 + 320); }
}

__device__ __forceinline__ void p1_norm_mod(const Frame& F, const Args& A) {
    const float* mod = (const float*)(F.ws + WS_MOD);
    constexpr int NROWS = NTOK + NCTX;
    for (int row = F.bx * 8 + F.wave; row < NROWS; row += F.G * 8) {
        const bool isctx = row >= NTOK; const int r2 = isctx ? row - NTOK : row;
        const float* src = isctx ? ldp(F, I_CTX) + (size_t)r2 * DM : ldp(F, I_X) + (size_t)r2 * DM;
        bf16_t* dst = isctx ? (bf16_t*)(F.ws + WS_HCTX) + (size_t)r2 * DM : (bf16_t*)(F.ws + WS_HLAT) + (size_t)r2 * DM;
        const float* mrow = mod + (size_t)(isctx ? 8 : (r2 / SEQ)) * (6 * DM);
        f32x4 v[8]; float ss = 0.f;
#pragma unroll
        for (int j = 0; j < 8; ++j) { v[j] = __builtin_nontemporal_load((const f32x4*)(src + 4 * F.lane + 256 * j)); ss += v[j][0] * v[j][0] + v[j][1] * v[j][1] + v[j][2] * v[j][2] + v[j][3] * v[j][3]; }
        ss = wave_sum(ss); const float rstd = rsqrtf(ss * (1.0f / DM) + EPS);
#pragma unroll
        for (int j = 0; j < 8; ++j) { const int col = 4 * F.lane + 256 * j;
            const f32x4 w = *(const f32x4*)(ldp(F, I_PRE_MIX) + col), sh = *(const f32x4*)(mrow + col), sc = *(const f32x4*)(mrow + DM + col);
            f32x4 y;
#pragma unroll
            for (int i = 0; i < 4; ++i) y[i] = v[j][i] * rstd * w[i] * (1.0f + sc[i]) + sh[i];
            u32x2 o; o.x = cvt_pk_bf16(y[0], y[1]); o.y = cvt_pk_bf16(y[2], y[3]); *(u32x2*)(dst + col) = o;
            if (!isctx) *(unsigned*)(F.ws + WS_H8 + (size_t)r2 * DM + col) = cvt4_fp8(y[0] * FP8_AS, y[1] * FP8_AS, y[2] * FP8_AS, y[3] * FP8_AS); }
    }
}

struct SchedIn {
    int G, c, r0, nr; bool f8;
    __device__ __forceinline__ bool next(int i_, pg8::Unit& u) const {
        const int i = r0 + i_;
        constexpr int nN = 12, NLAT = 64 * nN; const long L = (long)i * G + c; int pm = 0, pn = 0, aux = 0; bool ok;
        if (i_ >= nr) { u.pm = 0; u.pn = 0; u.aux = 0; return false; }
        if (L < NLAT) { ok = pg8::static_order(64, nN, G, c, i, pm, pn); pn = f8 ? (pn < 4 ? 8 + pn : 12 + pn) : (pn < 8 ? pn : pn + 4); }
        else if (!f8) { const int q = (int)(L - NLAT); ok = q < 64; aux = 1; pm = q & 7; pn = 4 + (q >> 3); }
        else ok = false;
        u.pm = pm; u.pn = pn; u.aux = aux; return ok; }
    __device__ __forceinline__ unsigned abase(const pg8::Unit& u) const { return f8 ? (unsigned)WS_H8 + (unsigned)u.pm * (256u * DM) : (unsigned)WS_HLAT + (unsigned)u.aux * (unsigned)(WS_HCTX - WS_HLAT) + (unsigned)u.pm * (256u * DM * 2u); }
    __device__ __forceinline__ unsigned bbase(const pg8::Unit& u) const { return f8 ? (unsigned)WS_WIN8 + (unsigned)(u.pn >= 16 ? u.pn - 16 : u.pn) * (256u * DM) : (unsigned)WS_WIN + (unsigned)u.pn * (256u * DM * 2u); }
};
struct EpiGlu8 { unsigned char* ws;
    __device__ __forceinline__ void operator()(const f32x4 (&acc)[2][2][4][2], const pg8::Unit& u, int wr, int wc, int fr_, int fq_) const {
        const int ln_ = get_lane(); const int fr = ln_ & 15, fq = ln_ >> 4; (void)fr_; (void)fq_;
        const int row0 = u.pm * 256 + wr * 64 + fr, tl = u.pn - 16; bf16_t* base = (bf16_t*)(ws + WS_U);
        if (u.pn < 16) {
            const int pnl = u.pn & 3; bf16_t* vb = (bf16_t*)(ws + WS_V);
#pragma unroll
            for (int ai = 0; ai < 2; ++ai)
#pragma unroll
                for (int m = 0; m < 4; ++m) { const int row = row0 + ai * 128 + m * 16;
#pragma unroll
                    for (int bj = 0; bj < 2; ++bj) { const f32x4 a = acc[ai][bj][m][0] * FP8_DESCALE, b = acc[ai][bj][m][1] * FP8_DESCALE;
                        u32x4 w; w.x = cvt_pk_bf16(a[0], a[1]); w.y = cvt_pk_bf16(a[2], a[3]); w.z = cvt_pk_bf16(b[0], b[1]); w.w = cvt_pk_bf16(b[2], b[3]);
                        *(u32x4*)(vb + (unsigned)(row * DRET + 256 * pnl + 128 * bj + 32 * wc + 8 * fq)) = w; } }
            return; }
#pragma unroll
        for (int ai = 0; ai < 2; ++ai)
#pragma unroll
            for (int m = 0; m < 4; ++m) { const int row = row0 + ai * 128 + m * 16; float o[8];
#pragma unroll
                for (int n = 0; n < 2; ++n)
#pragma unroll
                    for (int i = 0; i < 4; ++i) o[4 * n + i] = (acc[ai][0][m][n][i] * FP8_DESCALE) * sigmoidf_(acc[ai][1][m][n][i] * FP8_DESCALE);
                u32x4 w; w.x = cvt_pk_bf16(o[0], o[1]); w.y = cvt_pk_bf16(o[2], o[3]); w.z = cvt_pk_bf16(o[4], o[5]); w.w = cvt_pk_bf16(o[6], o[7]);
                *(u32x4*)(base + (unsigned)(row * DCONV + 128 * tl + 32 * wc + 8 * fq)) = w; } } };
struct EpiIn {
    unsigned char* ws;
    __device__ __forceinline__ void operator()(const f32x4 (&acc)[2][2][4][2], const pg8::Unit& u, int wr, int wc, int fr_, int fq_) const {
        const int ln_ = get_lane(); const int fr = ln_ & 15, fq = ln_ >> 4; (void)fr_; (void)fq_;
        const int row0 = u.pm * 256 + wr * 64 + fr;
        if (u.pn < 8) {
            const bool isq = u.pn < 4; const int pnl = u.pn & 3;
            bf16_t* base = (bf16_t*)(ws + (u.aux ? WS_KC : (isq ? WS_Q : WS_K)));
            const float scl = isq ? 0.08838834764831845f : 1.0f;
            const int j0 = 16 * wc + 4 * fq;
            float inv[4];
#pragma unroll
            for (int i = 0; i < 4; ++i) inv[i] = exp2f(-(float)(j0 + i) * (13.287712379549449f / 64.0f));
#pragma unroll
            for (int ai = 0; ai < 2; ++ai)
#pragma unroll
                for (int m = 0; m < 4; ++m) { const int row = row0 + ai * 128 + m * 16;
                    const float pos = u.aux ? (float)(row & (CTXL - 1)) : (float)(CTXL + (row & (SEQ - 1)));
                    f32x4 cs, sn;
#pragma unroll
                    for (int i = 0; i < 4; ++i) { float t = pos * inv[i] * 0.15915494309189535f; t = t - rintf(t); sn[i] = __builtin_amdgcn_sinf(t) * scl; cs[i] = __builtin_amdgcn_cosf(t) * scl; }
#pragma unroll
                    for (int bj = 0; bj < 2; ++bj) { const f32x4 t1 = acc[ai][bj][m][0], t2 = acc[ai][bj][m][1];
                        const f32x4 o1 = t1 * cs - t2 * sn, o2 = t1 * sn + t2 * cs;
                        bf16_t* p = base + (unsigned)(row * DRET + 128 * (2 * pnl + bj) + j0);
                        u32x2 w1; w1.x = cvt_pk_bf16(o1[0], o1[1]); w1.y = cvt_pk_bf16(o1[2], o1[3]); *(u32x2*)p = w1;
                        u32x2 w2; w2.x = cvt_pk_bf16(o2[0], o2[1]); w2.y = cvt_pk_bf16(o2[2], o2[3]); *(u32x2*)(p + 64) = w2; } }
        } else if (u.pn < 16) {
            const bool isv = u.pn < 12; const int pnl = u.pn & 3;
            bf16_t* base = (bf16_t*)(ws + (u.aux ? WS_VC : (isv ? WS_V : WS_G)));
#pragma unroll
            for (int ai = 0; ai < 2; ++ai)
#pragma unroll
                for (int m = 0; m < 4; ++m) { const int row = row0 + ai * 128 + m * 16;
#pragma unroll
                    for (int bj = 0; bj < 2; ++bj) { f32x4 a = acc[ai][bj][m][0], b = acc[ai][bj][m][1];
                        if (!isv) {
#pragma unroll
                            for (int i = 0; i < 4; ++i) { a[i] = siluf_(a[i]); b[i] = siluf_(b[i]); } }
                        u32x4 w; w.x = cvt_pk_bf16(a[0], a[1]); w.y = cvt_pk_bf16(a[2], a[3]); w.z = cvt_pk_bf16(b[0], b[1]); w.w = cvt_pk_bf16(b[2], b[3]);
                        *(u32x4*)(base + (unsigned)(row * DRET + 256 * pnl + 128 * bj + 32 * wc + 8 * fq)) = w; } }
        } else {
            const int tl = u.pn - 16; bf16_t* base = (bf16_t*)(ws + WS_U);
#pragma unroll
            for (int ai = 0; ai < 2; ++ai)
#pragma unroll
                for (int m = 0; m < 4; ++m) { const int row = row0 + ai * 128 + m * 16; float o[8];
#pragma unroll
                    for (int n = 0; n < 2; ++n)
#pragma unroll
                        for (int i = 0; i < 4; ++i) o[4 * n + i] = acc[ai][0][m][n][i] * sigmoidf_(acc[ai][1][m][n][i]);
                    u32x4 w; w.x = cvt_pk_bf16(o[0], o[1]); w.y = cvt_pk_bf16(o[2], o[3]); w.z = cvt_pk_bf16(o[4], o[5]); w.w = cvt_pk_bf16(o[6], o[7]);
                    *(u32x4*)(base + (unsigned)(row * DCONV + 128 * tl + 32 * wc + 8 * fq)) = w; }
        }
    }
};

constexpr int IMGP = 272, IMGB = 128 * IMGP;
__device__ __forceinline__ unsigned img_row_base(unsigned lane) { return (lane & 15) * IMGP + 16 * (lane >> 4); }
__device__ __forceinline__ unsigned img_tr_base(unsigned lane) { return (8 * (lane >> 4) + ((lane & 15) >> 2)) * IMGP + 8 * (lane & 3); }
__device__ __forceinline__ bf16x8 tr_frag(const LAS unsigned char* img, unsigned trb, int c, int ks) {
    const s16x4 a = __builtin_amdgcn_ds_read_tr16_b64_v4i16((LAS s16x4*)(img + trb + ks * 32 * IMGP + c * 32));
    const s16x4 b = __builtin_amdgcn_ds_read_tr16_b64_v4i16((LAS s16x4*)(img + trb + ks * 32 * IMGP + 4 * IMGP + c * 32));
    bf16x8 r; r[0] = a[0]; r[1] = a[1]; r[2] = a[2]; r[3] = a[3]; r[4] = b[0]; r[5] = b[1]; r[6] = b[2]; r[7] = b[3]; return r; }

__device__ __forceinline__ void p3_state_unit(const Frame& F, const Args& A, int unit) {
    const int eh = unit & 1, dir = (unit >> 1) & 1, bh = unit >> 2, b = bh >> 3, h = bh & 7;
    const float lg = log_sigmoid_(dir ? ldp(F, I_DEC_B)[h] : ldp(F, I_DEC_F)[h]);
    const float dchunk = __expf(lg * (float)CHUNK);
    static_assert(4 * IMGB <= RING_BYTES, "state scan LDS"); LAS unsigned char* Kimg = F.lds;
    bf16_t* ST = (bf16_t*)(F.ws + (dir ? WS_SB : WS_SF)) + (size_t)bh * NCHUNK * HD * HD;
    const bf16_t* kl = (const bf16_t*)(F.ws + WS_K); const bf16_t* vl = (const bf16_t*)(F.ws + WS_V);
    const bf16_t* kc = (const bf16_t*)(F.ws + WS_KC); const bf16_t* vc = (const bf16_t*)(F.ws + WS_VC);
    f32x4 acc[4];
#pragma unroll
    for (int c = 0; c < 4; ++c) acc[c] = (f32x4){0.f, 0.f, 0.f, 0.f};
    int lane = F.lane; const int w = F.wave;
    asm volatile("" : "+v"(lane));
    const unsigned trb = img_tr_base((unsigned)lane);
    u32x4 kreg[4], vreg[2];
#define P3_LOAD(step_) do { const int _s = (step_); const bool _ic = _s < 2; const int _ci = _ic ? (dir ? 1 - _s : _s) : (dir ? 17 - _s : _s - 2); \
        const size_t _t0 = _ic ? (size_t)b * CTXL + _ci * CHUNK : (size_t)b * SEQ + _ci * CHUNK; \
        const bf16_t* _ks = (_ic ? kc : kl) + _t0 * DRET + h * HD; const bf16_t* _vs = (_ic ? vc : vl) + _t0 * DRET + h * HD + 64 * eh; \
        _Pragma("unroll") for (int j = 0; j < 4; ++j) { const int idx = F.tid + 512 * j; kreg[j] = *(const u32x4*)(_ks + (size_t)(idx >> 4) * DRET + (idx & 15) * 8); } \
        _Pragma("unroll") for (int j = 0; j < 2; ++j) { const int idx = F.tid + 512 * j; vreg[j] = *(const u32x4*)(_vs + (size_t)(idx >> 3) * DRET + (idx & 7) * 8); } } while (0)
#define P3_WRITE(step_) do { LAS unsigned char* _K = Kimg + ((step_) & 1) * 2 * IMGB; LAS unsigned char* _V = _K + IMGB; \
        _Pragma("unroll") for (int j = 0; j < 4; ++j) { const int idx = F.tid + 512 * j; *(LAS u32x4*)(_K + (idx >> 4) * IMGP + (idx & 15) * 16) = kreg[j]; } \
        _Pragma("unroll") for (int j = 0; j < 2; ++j) { const int idx = F.tid + 512 * j, row = idx >> 3, ch = 8 * eh + (idx & 7); const u32x4 vv = vreg[j]; \
            const float wt = __expf(lg * (float)(dir ? row : (CHUNK - 1 - row)));                \
            u32x4 o; o.x = cvt_pk_bf16(bf_lo(vv.x) * wt, bf_hi(vv.x) * wt); o.y = cvt_pk_bf16(bf_lo(vv.y) * wt, bf_hi(vv.y) * wt); \
            o.z = cvt_pk_bf16(bf_lo(vv.z) * wt, bf_hi(vv.z) * wt); o.w = cvt_pk_bf16(bf_lo(vv.w) * wt, bf_hi(vv.w) * wt); \
            *(LAS u32x4*)(_V + row * IMGP + ch * 16) = o; } } while (0)
    __syncthreads();
    P3_LOAD(0); P3_WRITE(0); P3_LOAD(1);
    __syncthreads();
    for (int step = 0; step < 18; ++step) {
        const bool isctx = step < 2; const int ci = isctx ? (dir ? 1 - step : step) : (dir ? 17 - step : step - 2);
        if (!isctx) {
#pragma unroll
            for (int c = 0; c < 4; ++c) { const int e = 64 * eh + 16 * c + (lane & 15), d0 = 16 * w + 4 * (lane >> 4);
                u32x2 o; o.x = cvt_pk_bf16(acc[c][0], acc[c][1]); o.y = cvt_pk_bf16(acc[c][2], acc[c][3]);
                *(u32x2*)(ST + ((size_t)ci * HD + e) * HD + d0) = o; }
            if (step == 17) break;
        }
        if (step + 1 < 17) { P3_WRITE(step + 1); if (step + 2 < 17) P3_LOAD(step + 2); }
        { LAS unsigned char* Kc = Kimg + (step & 1) * 2 * IMGB; LAS unsigned char* Vc = Kc + IMGB;
#pragma unroll
        for (int c = 0; c < 4; ++c) { acc[c][0] *= dchunk; acc[c][1] *= dchunk; acc[c][2] *= dchunk; acc[c][3] *= dchunk; }
#pragma unroll
        for (int ks = 0; ks < 4; ++ks) { const bf16x8 af = tr_frag(Kc, trb, w, ks);
#pragma unroll
            for (int c = 0; c < 4; ++c) { const bf16x8 bfr = tr_frag(Vc, trb, 4 * eh + c, ks);
                acc[c] = __builtin_amdgcn_mfma_f32_16x16x32_bf16(af, bfr, acc[c], 0, 0, 0); } } }
        __syncthreads();
    }
#undef P3_WRITE
#undef P3_LOAD
    __syncthreads();
}

__device__ __forceinline__ void p3_conv_unit(const Frame& F, const Args& A, int sq) {
    LAS bf16_t* T = (LAS bf16_t*)F.lds;
    const size_t tok0 = (size_t)sq * GRIDW;
    const bf16_t* usrc = (const bf16_t*)(F.ws + WS_U) + tok0 * DCONV;
    __syncthreads();
#pragma unroll
    for (int j = 0; j < 16; ++j) { const int idx = F.tid + 512 * j; *(LAS u32x4*)(F.lds + idx * 16) = __builtin_nontemporal_load((const u32x4*)(usrc + (size_t)idx * 8)); }
    __syncthreads();
    {
        const int ch = 2 * F.tid;
        f32x2 wv[CONVW];
#pragma unroll
        for (int t = 0; t < CONVW; ++t) wv[t] = *(const f32x2*)(ldp(F, I_CONV_W) + t * DCONV + ch);
        const f32x2 bias = *(const f32x2*)(ldp(F, I_CONV_B) + ch);
        f32x2 prev[16];
#pragma unroll
        for (int i = 0; i < 16; ++i) prev[i] = (f32x2){0.f, 0.f};
        for (int cb = 0; cb < 4; ++cb) {
            const int p0 = cb * 16; f32x2 a[16];
#pragma unroll
            for (int i = 0; i < 16; ++i) a[i] = bias;
#pragma unroll
            for (int qb = 0; qb < 6; ++qb) { f32x2 xin[8];
#pragma unroll
                for (int k = 0; k < 8; ++k) { const int qq = qb * 8 + k, q = p0 - CONVP + qq; const bool ok = (qq < 46) && (q >= 0) && (q < GRIDW);
                    const unsigned uu = ok ? *(const LAS unsigned*)(T + (ok ? q : 0) * DCONV + ch) : 0u; xin[k] = (f32x2){bf_lo(uu), bf_hi(uu)}; }
#pragma unroll
                for (int k = 0; k < 8; ++k) { const int qq = qb * 8 + k;
#pragma unroll
                    for (int i = 0; i < 16; ++i) { const int tap = qq - i;
                        if (qq < 46 && tap >= 0 && tap < CONVW) a[i] += wv[tap] * xin[k]; } }
                asm volatile("" ::: "memory"); }
            if (cb > 0) {
#pragma unroll
                for (int i = 0; i < 16; ++i) *(LAS unsigned*)(T + (p0 - 16 + i) * DCONV + ch) = cvt_pk_bf16(prev[i][0], prev[i][1]); }
#pragma unroll
            for (int i = 0; i < 16; ++i) prev[i] = a[i];
        }
#pragma unroll
        for (int i = 0; i < 16; ++i) *(LAS unsigned*)(T + (48 + i) * DCONV + ch) = cvt_pk_bf16(prev[i][0], prev[i][1]);
    }
    __syncthreads();
    float lw[16], lb[16];
#pragma unroll
    for (int i = 0; i < 16; ++i) { lw[i] = ldp(F, I_LN_W)[16 * F.lane + i]; lb[i] = ldp(F, I_LN_B)[16 * F.lane + i]; }
    unsigned char* ydst = F.ws + WS_Y;
    for (int p = F.wave; p < GRIDW; p += 8) {
        const u32x4 r0 = *(const LAS u32x4*)(F.lds + p * 2048 + F.lane * 32), r1 = *(const LAS u32x4*)(F.lds + p * 2048 + F.lane * 32 + 16);
        float v[16]; const unsigned rr[8] = {r0.x, r0.y, r0.z, r0.w, r1.x, r1.y, r1.z, r1.w};
#pragma unroll
        for (int i = 0; i < 8; ++i) { v[2 * i] = bf_lo(rr[i]); v[2 * i + 1] = bf_hi(rr[i]); }
        float s = 0.f;
#pragma unroll
        for (int i = 0; i < 16; ++i) s += v[i];
        const float mu = wave_sum(s) * (1.0f / DCONV); float q = 0.f;
#pragma unroll
        for (int i = 0; i < 16; ++i) { const float d = v[i] - mu; q += d * d; }
        const float rstd = rsqrtf(wave_sum(q) * (1.0f / DCONV) + EPS);
        float yv[16];
#pragma unroll
        for (int i = 0; i < 16; ++i) yv[i] = siluf_((v[i] - mu) * rstd * lw[i] + lb[i]) * FP8_AS;
        *(u32x4*)(ydst + (tok0 + p) * DM + DRET + 16 * F.lane) = (u32x4){cvt4_fp8(yv[0], yv[1], yv[2], yv[3]), cvt4_fp8(yv[4], yv[5], yv[6], yv[7]), cvt4_fp8(yv[8], yv[9], yv[10], yv[11]), cvt4_fp8(yv[12], yv[13], yv[14], yv[15])};
    }
    __syncthreads();
}

__device__ __forceinline__ void p4_retention(const Frame& F, const Args& A) {
    static_assert(4 * IMGB <= RING_BYTES, "retention phase LDS");
    const int lane0 = F.lane, w = F.wave;
    LAS unsigned char* Kimg = F.lds; LAS unsigned char* Vimg = F.lds + IMGB; LAS unsigned char* Bimg = F.lds + 2 * IMGB; LAS unsigned char* Pimg = F.lds + 3 * IMGB + w * (16 * IMGP);
    const bf16_t* kall = (const bf16_t*)(F.ws + WS_K); const bf16_t* vall = (const bf16_t*)(F.ws + WS_V); const bf16_t* qall = (const bf16_t*)(F.ws + WS_Q);
    u32x4 kreg[4], vreg[4]; bf16x8 qn[4];
#define P4_LOAD(u_) do { const int _ci = (u_) & 15, _bh = (u_) >> 4; const size_t _o = ((size_t)(_bh >> 3) * SEQ + _ci * CHUNK) * DRET + (_bh & 7) * HD; \
        _Pragma("unroll") for (int j = 0; j < 4; ++j) { const int idx = (w * 64 + lane) + 512 * j; kreg[j] = *(const u32x4*)(kall + _o + (size_t)(idx >> 4) * DRET + (idx & 15) * 8); vreg[j] = *(const u32x4*)(vall + _o + (size_t)(idx >> 4) * DRET + (idx & 15) * 8); } \
        _Pragma("unroll") for (int ks = 0; ks < 4; ++ks) qn[ks] = *(const bf16x8*)(qall + _o + (size_t)(16 * w + (lane & 15)) * DRET + 32 * ks + 8 * (lane >> 4)); } while (0)
    int unit = F.bx;
    { const int lane = lane0; if (unit < 1024) P4_LOAD(unit); }
    for (; unit < 1024; unit += F.G) {
        int lane = lane0; asm volatile("" : "+v"(lane));
        const unsigned rwb = img_row_base((unsigned)lane), trb = img_tr_base((unsigned)lane);
        const int ci = unit & 15, bh = unit >> 4, b = bh >> 3, h = bh & 7;
        const float lgf = log_sigmoid_(ldp(F, I_DEC_F)[h]), lgb = log_sigmoid_(ldp(F, I_DEC_B)[h]);
        const float lf2 = lgf * 1.4426950408889634f, lb2 = lgb * 1.4426950408889634f;
        const size_t tok0 = (size_t)b * SEQ + ci * CHUNK;
        __syncthreads();
#pragma unroll
        for (int j = 0; j < 4; ++j) { const int idx = F.tid + 512 * j; *(LAS u32x4*)(Kimg + (idx >> 4) * IMGP + (idx & 15) * 16) = kreg[j]; *(LAS u32x4*)(Vimg + (idx >> 4) * IMGP + (idx & 15) * 16) = vreg[j]; }
        bf16x8 qf[4];
#pragma unroll
        for (int ks = 0; ks < 4; ++ks) qf[ks] = qn[ks];
        const bf16_t* sfp = (const bf16_t*)(F.ws + WS_SF) + ((size_t)bh * NCHUNK + ci) * HD * HD; const bf16_t* sbp = (const bf16_t*)(F.ws + WS_SB) + ((size_t)bh * NCHUNK + ci) * HD * HD;
        u32x4 sfr[4], sbr[4];
#pragma unroll
        for (int j = 0; j < 4; ++j) { const int idx = F.tid + 512 * j; sfr[j] = __builtin_nontemporal_load((const u32x4*)(sfp + (size_t)idx * 8)); sbr[j] = __builtin_nontemporal_load((const u32x4*)(sbp + (size_t)idx * 8)); }
        __syncthreads();
        const int tl = 16 * w + (lane & 15);
#pragma unroll
        for (int c = 0; c < 8; ++c) { f32x4 sc = (f32x4){0.f, 0.f, 0.f, 0.f};
#pragma unroll
            for (int ks = 0; ks < 4; ++ks) { const bf16x8 kf = *(const LAS bf16x8*)(Kimg + rwb + c * 16 * IMGP + ks * 64); sc = __builtin_amdgcn_mfma_f32_16x16x32_bf16(kf, qf[ks], sc, 0, 0, 0); }
            float p[4];
#pragma unroll
            for (int r = 0; r < 4; ++r) { const int s = 16 * c + 4 * (lane >> 4) + r, dt = tl - s;
                const float df = (dt >= 0) ? __builtin_amdgcn_exp2f(lf2 * (float)dt) : 0.f, db = (dt <= 0) ? __builtin_amdgcn_exp2f(lb2 * (float)(-dt)) : 0.f;
                p[r] = sc[r] * (df + db); }
            u32x2 o; o.x = cvt_pk_bf16(p[0], p[1]); o.y = cvt_pk_bf16(p[2], p[3]);
            *(LAS u32x2*)(Pimg + (lane & 15) * IMGP + 32 * c + 8 * (lane >> 4)) = o; }
        __syncthreads();
#pragma unroll
        for (int j = 0; j < 4; ++j) { const int idx = F.tid + 512 * j; *(LAS u32x4*)(Kimg + (idx >> 4) * IMGP + (idx & 15) * 16) = sfr[j]; *(LAS u32x4*)(Bimg + (idx >> 4) * IMGP + (idx & 15) * 16) = sbr[j]; }
        __syncthreads();
        if (unit + F.G < 1024) P4_LOAD(unit + F.G);
        const bf16_t* gsrc = (const bf16_t*)(F.ws + WS_G) + (tok0 + tl) * DRET + h * HD;
        u32x2 gg[8];
#pragma unroll
        for (int c = 0; c < 8; ++c) gg[c] = __builtin_nontemporal_load((const u32x2*)(gsrc + 16 * c + 4 * (lane >> 4)));
        bf16x8 pf[4];
#pragma unroll
        for (int ks = 0; ks < 4; ++ks) pf[ks] = *(const LAS bf16x8*)(Pimg + rwb + ks * 64);
        const float af = __expf(lgf * (float)(tl + 1)), ab = __expf(lgb * (float)(CHUNK - tl));
        f32x4 o[8];
#pragma unroll
        for (int c = 0; c < 8; ++c) { f32x4 a = (f32x4){0.f, 0.f, 0.f, 0.f}, f = a, g = a;
#pragma unroll
            for (int ks = 0; ks < 4; ++ks) { const bf16x8 vf = tr_frag(Vimg, trb, c, ks); a = __builtin_amdgcn_mfma_f32_16x16x32_bf16(vf, pf[ks], a, 0, 0, 0); }
#pragma unroll
            for (int ks = 0; ks < 4; ++ks) { const bf16x8 s1 = *(const LAS bf16x8*)(Kimg + rwb + c * 16 * IMGP + ks * 64); f = __builtin_amdgcn_mfma_f32_16x16x32_bf16(s1, qf[ks], f, 0, 0, 0); }
#pragma unroll
            for (int ks = 0; ks < 4; ++ks) { const bf16x8 s2 = *(const LAS bf16x8*)(Bimg + rwb + c * 16 * IMGP + ks * 64); g = __builtin_amdgcn_mfma_f32_16x16x32_bf16(s2, qf[ks], g, 0, 0, 0); }
#pragma unroll
            for (int r = 0; r < 4; ++r) o[c][r] = a[r] + af * f[r] + ab * g[r]; }
        float s = 0.f;
#pragma unroll
        for (int c = 0; c < 8; ++c) s += (o[c][0] + o[c][1]) + (o[c][2] + o[c][3]);
        s += __shfl_xor(s, 16); s += __shfl_xor(s, 32);
        const float mu = s * (1.0f / HD); float q2 = 0.f;
#pragma unroll
        for (int c = 0; c < 8; ++c)
#pragma unroll
            for (int r = 0; r < 4; ++r) { const float d = o[c][r] - mu; q2 += d * d; }
        q2 += __shfl_xor(q2, 16); q2 += __shfl_xor(q2, 32);
        const float rstd = rsqrtf(q2 * (1.0f / HD) + GN_EPS);
        unsigned char* ydst = F.ws + WS_Y + (tok0 + tl) * DM + h * HD;
        const float* gnw = ldp(F, I_GN_W) + h * HD;
#pragma unroll
        for (int c = 0; c < 8; ++c) { const int e0 = 16 * c + 4 * (lane >> 4);
            const f32x4 gw = *(const f32x4*)(gnw + e0);
            const float y0 = (o[c][0] - mu) * rstd * gw[0] * bf_lo(gg[c].x), y1 = (o[c][1] - mu) * rstd * gw[1] * bf_hi(gg[c].x), y2 = (o[c][2] - mu) * rstd * gw[2] * bf_lo(gg[c].y), y3 = (o[c][3] - mu) * rstd * gw[3] * bf_hi(gg[c].y);
            *(unsigned*)(ydst + e0) = cvt4_fp8(y0 * FP8_AS, y1 * FP8_AS, y2 * FP8_AS, y3 * FP8_AS); }
    }
#undef P4_LOAD
    __syncthreads();
}

struct SchedDense { unsigned a, bt; int nM, nN, G, c; unsigned RB; int r0, nr;
    __device__ __forceinline__ bool next(int i, pg8::Unit& u) const { u.aux = 0; int pm = 0, pn = 0; const bool ok = (i < nr) && pg8::static_order(nM, nN, G, c, r0 + i, pm, pn); u.pm = pm; u.pn = pn; return ok; }
    __device__ __forceinline__ unsigned abase(const pg8::Unit& u) const { return a + (unsigned)u.pm * 256u * RB; }
    __device__ __forceinline__ unsigned bbase(const pg8::Unit& u) const { return bt + (unsigned)u.pn * 256u * RB; } };
struct EpiBf16 { bf16_t* C; int ldc; float sc;
    __device__ __forceinline__ void operator()(const f32x4 (&acc)[2][2][4][2], const pg8::Unit& u, int wr, int wc, int fr_, int fq_) const {
        const int ln_ = get_lane(); const int fr = ln_ & 15, fq = ln_ >> 4; (void)fr_; (void)fq_;
        const int row0 = u.pm * 256 + wr * 64 + fr, col0 = u.pn * 256 + wc * 32 + 8 * fq;
#pragma unroll
        for (int ai = 0; ai < 2; ++ai)
#pragma unroll
            for (int m = 0; m < 4; ++m) { bf16_t* rowp = C + (unsigned)((row0 + ai * 128 + m * 16) * ldc + col0);
#pragma unroll
                for (int bj = 0; bj < 2; ++bj) { const f32x4 a = acc[ai][bj][m][0] * sc, b = acc[ai][bj][m][1] * sc;
                    u32x4 w; w.x = cvt_pk_bf16(a[0], a[1]); w.y = cvt_pk_bf16(a[2], a[3]); w.z = cvt_pk_bf16(b[0], b[1]); w.w = cvt_pk_bf16(b[2], b[3]);
                    *(u32x4*)(rowp + bj * 128) = w; } } } };

__device__ __forceinline__ void p6_mid(const Frame& F, const Args& A) {
    constexpr int PITCH = 4112;
    LAS unsigned char* tile = F.lds;
    LAS float* red = (LAS float*)(F.lds + 16 * PITCH);
    LAS int* lcnt = (LAS int*)(red + 8 * 16 * 32);
    LAS int* lbase = lcnt + 32;
    LAS int* tk_e = lbase + 32;
    LAS int* tk_ls = tk_e + 256;
    LAS float* PW = (LAS float*)(tk_ls + 256); LAS float* FW = PW + DM; LAS float* MODB = FW + DM;
    static_assert(16 * 4112 + 8 * 16 * 32 * 4 + (32 + 32 + 256 + 256) * 4 + 5 * DM * 4 <= RING_BYTES, "P6 LDS");
    const float* mod = (const float*)(F.ws + WS_MOD); const bf16_t* mix = (const bf16_t*)(F.ws + WS_MIX);
    bf16_t* x1p = (bf16_t*)(F.ws + WS_X1); unsigned char* h2p = F.ws + WS_H2;       const bf16_t* rwt = (const bf16_t*)(F.ws + WS_RWT);
    int* toke = (int*)(F.ws + WS_TOKE); float* tokg = (float*)(F.ws + WS_TOKG); int* toks = (int*)(F.ws + WS_TOKS); int* list = (int*)(F.ws + WS_LIST);
    const float* xin = ldp(F, I_X); const float* post_mix = ldp(F, I_POST_MIX); const float* pre_ffn = ldp(F, I_PRE_FFN);
    const int lane = F.lane, w = F.wave;
    if (F.tid < 32) lcnt[F.tid] = 0;
    { const f32x4 a = *(const f32x4*)(post_mix + 4 * F.tid), b = *(const f32x4*)(pre_ffn + 4 * F.tid); *(LAS f32x4*)(PW + 4 * F.tid) = a; *(LAS f32x4*)(FW + 4 * F.tid) = b; }
    __syncthreads();
    constexpr int NT = NTOK / 16;
    u32x2 mv[2][8]; f32x4 xv[2][8];
#define P6_LOAD(it_) do { _Pragma("unroll") for (int rr = 0; rr < 2; ++rr) { const size_t ro = (size_t)((it_) * 16 + 2 * w + rr) * DM + 4 * lane; \
        _Pragma("unroll") for (int j = 0; j < 8; ++j) { mv[rr][j] = *(const u32x2*)(mix + ro + 256 * j); xv[rr][j] = __builtin_nontemporal_load((const f32x4*)(xin + ro + 256 * j)); } } } while (0)
    const __amdgpu_buffer_rsrc_t rsm = __builtin_amdgcn_make_buffer_rsrc((void*)F.ws, 0, -1, 0x00020000);
#define P6_LOADM(it_) do { const unsigned _so = (unsigned)WS_MOD + (unsigned)(((it_) * 16) / SEQ) * (unsigned)(6 * DM * 4) + (unsigned)(2 * DM * 4) + (unsigned)w * 1024u; \
        _Pragma("unroll") for (int k = 0; k < 3; ++k) __builtin_amdgcn_raw_ptr_buffer_load_lds(rsm, (LAS void*)((LAS unsigned char*)MODB + k * (DM * 4) + w * 1024), 16, (unsigned)lane * 16u, _so + (unsigned)(k * DM * 4), 0, 0); } while (0)
    int it = F.bx, ti = 0;
    if (it < NT) { P6_LOADM(it); P6_LOAD(it); }
    for (; it < NT; it += F.G, ++ti) {
        const int r0 = it * 16;
        float r1[2], r2[2], ss2[2] = {0.f, 0.f};
#pragma unroll
        for (int rr = 0; rr < 2; ++rr) { float ss = 0.f;
#pragma unroll
            for (int j = 0; j < 8; ++j) { const float m0 = bf_lo(mv[rr][j].x), m1 = bf_hi(mv[rr][j].x), m2 = bf_lo(mv[rr][j].y), m3 = bf_hi(mv[rr][j].y); ss += m0 * m0 + m1 * m1 + m2 * m2 + m3 * m3; }
            r1[rr] = rsqrtf(wave_sum(ss) * (1.0f / DM) + EPS); }
        asm volatile("s_waitcnt vmcnt(0)" ::: "memory");
        __syncthreads();
#pragma unroll
        for (int j = 0; j < 8; ++j) { const int col = 4 * lane + 256 * j; const f32x4 pw = *(const LAS f32x4*)(PW + col), g1 = *(const LAS f32x4*)(MODB + col);
#pragma unroll
            for (int rr = 0; rr < 2; ++rr) { unsigned m0_ = mv[rr][j].x, m1_ = mv[rr][j].y; asm volatile("" : "+v"(m0_), "+v"(m1_));
                const float mm[4] = {bf_lo(m0_), bf_hi(m0_), bf_lo(m1_), bf_hi(m1_)};
#pragma unroll
                for (int i = 0; i < 4; ++i) { xv[rr][j][i] += g1[i] * (mm[i] * r1[rr] * pw[i]); ss2[rr] += xv[rr][j][i] * xv[rr][j][i]; }
                u32x2 xo; xo.x = cvt_pk_bf16(xv[rr][j][0], xv[rr][j][1]); xo.y = cvt_pk_bf16(xv[rr][j][2], xv[rr][j][3]);
                __builtin_nontemporal_store(xo, (u32x2*)(x1p + (size_t)(r0 + 2 * w + rr) * DM + col)); }
            asm volatile("" ::: "memory"); }
#pragma unroll
        for (int rr = 0; rr < 2; ++rr) r2[rr] = rsqrtf(wave_sum(ss2[rr]) * (1.0f / DM) + EPS);
#pragma unroll
        for (int j = 0; j < 8; ++j) { const int col = 4 * lane + 256 * j; const f32x4 fw = *(const LAS f32x4*)(FW + col), sh = *(const LAS f32x4*)(MODB + DM + col), sc = *(const LAS f32x4*)(MODB + 2 * DM + col);
#pragma unroll
            for (int rr = 0; rr < 2; ++rr) { const int rl = 2 * w + rr; float y[4];
#pragma unroll
                for (int i = 0; i < 4; ++i) y[i] = xv[rr][j][i] * r2[rr] * fw[i] * (1.0f + sc[i]) + sh[i];
                u32x2 o; o.x = cvt_pk_bf16(y[0], y[1]); o.y = cvt_pk_bf16(y[2], y[3]);
                *(unsigned*)(h2p + (size_t)(r0 + rl) * DM + col) = cvt4_fp8(y[0] * FP8_AS, y[1] * FP8_AS, y[2] * FP8_AS, y[3] * FP8_AS); *(LAS u32x2*)(tile + rl * PITCH + col * 2) = o; }
            asm volatile("" ::: "memory"); }
        __syncthreads();
        { f32x4 c0 = (f32x4){0.f, 0.f, 0.f, 0.f}, c1 = c0; bf16x8 b0[8], b1[8];
#pragma unroll
            for (int ks = 0; ks < 8; ++ks) { const int k0 = 256 * w + 32 * ks + 8 * (lane >> 4);
                b0[ks] = *(const bf16x8*)(rwt + (size_t)(lane & 15) * DM + k0); b1[ks] = *(const bf16x8*)(rwt + (size_t)(16 + (lane & 15)) * DM + k0); }
            asm volatile("" ::: "memory");
            if (it + F.G < NT) { P6_LOADM(it + F.G); P6_LOAD(it + F.G); }
            asm volatile("" ::: "memory");
#pragma unroll
            for (int ks = 0; ks < 8; ++ks) { const int k0 = 256 * w + 32 * ks + 8 * (lane >> 4);
                const bf16x8 a = *(const LAS bf16x8*)(tile + (lane & 15) * PITCH + k0 * 2);
                c0 = __builtin_amdgcn_mfma_f32_16x16x32_bf16(a, b0[ks], c0, 0, 0, 0); c1 = __builtin_amdgcn_mfma_f32_16x16x32_bf16(a, b1[ks], c1, 0, 0, 0); }
#pragma unroll
            for (int r = 0; r < 4; ++r) { red[(w * 16 + 4 * (lane >> 4) + r) * 32 + (lane & 15)] = c0[r]; red[(w * 16 + 4 * (lane >> 4) + r) * 32 + 16 + (lane & 15)] = c1[r]; } }
        __syncthreads();
        { const int rl = 2 * w + (lane >> 5), e = lane & 31, row = r0 + rl; float val = ldp(F, I_ROUTER_B)[e];
#pragma unroll
            for (int ww = 0; ww < 8; ++ww) val += red[(ww * 16 + rl) * 32 + e];
            float v[4]; int ix[4];
#pragma unroll
            for (int k = 0; k < 4; ++k) { float bv = val; int bi = e;
#pragma unroll
                for (int o = 1; o < 32; o <<= 1) { const float ov = __shfl_xor(bv, o); const int oi = __shfl_xor(bi, o); if (ov > bv || (ov == bv && oi < bi)) { bv = ov; bi = oi; } }
                v[k] = bv; ix[k] = bi; if (e == bi) val = -3.0e38f; }
            float gt[4], sum = 0.f;
#pragma unroll
            for (int k = 0; k < 4; ++k) { gt[k] = __expf(v[k] - v[0]); sum += gt[k]; }
            const float rs = 1.0f / sum;
#pragma unroll
            for (int k = 0; k < 4; ++k) if (e == ix[k]) { const int ls = atomicAdd((int*)&lcnt[e], 1); const int t = (ti * 16 + rl) * 4 + k;
                tk_e[t] = e; tk_ls[t] = ls; toke[row * 4 + k] = e; tokg[row * 4 + k] = gt[k] * rs; } }
    }
#undef P6_LOAD
#undef P6_LOADM
    __syncthreads();
    if (F.tid < 32) { const int n = lcnt[F.tid]; int base = 0; if (n > 0) base = (int)__hip_atomic_fetch_add(F.ctl + CW_CNT + 64 * F.tid, (unsigned)n, __ATOMIC_RELAXED, __HIP_MEMORY_SCOPE_AGENT); lbase[F.tid] = base; }
    __syncthreads();
    if (F.tid < ti * 64) { const int t = F.tid, tt = t >> 2, k = t & 3, e = tk_e[t], slot = lbase[e] + tk_ls[t], row = (F.bx + (tt >> 4) * F.G) * 16 + (tt & 15);
        toks[row * 4 + k] = slot; list[e * NTOK + slot] = row; }
    __syncthreads();
}

__device__ __forceinline__ int moe_tables(const Frame& F, int nN) {
    LAS int* toff = (LAS int*)(F.lds + MISC_OFF + 64); LAS int* cnt = (LAS int*)(F.lds + MISC_OFF + 256); LAS int* utab = (LAS int*)(F.lds + MISC_OFF + 512);
    __syncthreads();
    if (F.tid < 32) { int n = (int)__hip_atomic_load(F.ctl + CW_CNT + 64 * F.tid, __ATOMIC_RELAXED, __HIP_MEMORY_SCOPE_AGENT); n = n < 0 ? 0 : (n > NTOK ? NTOK : n); cnt[F.tid] = n; }
    __syncthreads();
    if (F.tid == 0) { int s = 0; for (int e = 0; e < 32; ++e) { toff[e] = s; s += (cnt[e] + 255) >> 8; } toff[32] = s; }
    __syncthreads();
    const int T = toff[32];
    if (F.tid < MAXU) { int v = -1; const int nwg = T * nN; const long L = (long)F.tid * F.G + F.bx;
        if (L < nwg) { int wgid = (int)L; { const int q = nwg / pg8::NXCD, r = nwg % pg8::NXCD, xcd = wgid % pg8::NXCD, off = wgid / pg8::NXCD; wgid = (xcd < r ? xcd * (q + 1) : r * (q + 1) + (xcd - r) * q) + off; }
            int e = 0; while (e < 31 && wgid >= toff[e + 1] * nN) ++e;
            const int loc = wgid - toff[e] * nN, ntl = toff[e + 1] - toff[e], pm = toff[e] + loc % ntl, pn = loc / ntl; v = pm | (pn << 12) | (e << 20); }
        utab[F.tid] = v; }
    __syncthreads();
    return T;
}
struct SchedMoe { unsigned a, bt; const LAS int* utab; const LAS int* toff; int nN; bool gather; int r0, nr;
    __device__ __forceinline__ bool next(int i_, pg8::Unit& u) const { const int i = r0 + i_; u.pm = 0; u.pn = 0; u.aux = 0; if (i_ >= nr || i >= MAXU) return false; const int v = __builtin_amdgcn_readfirstlane(utab[i]); if (v < 0) return false; u.pm = v & 4095; u.pn = (v >> 12) & 255; u.aux = v >> 20; return true; }
    __device__ __forceinline__ unsigned abase(const pg8::Unit& u) const { return gather ? a : a + (unsigned)u.pm * (256u * DM); }
    __device__ __forceinline__ unsigned bbase(const pg8::Unit& u) const { return bt + ((unsigned)u.aux * (unsigned)nN + (unsigned)u.pn) * (256u * DM); } };
struct EpiMoe1 { unsigned char* act; const float* b1;
    __device__ __forceinline__ void operator()(const f32x4 (&acc)[2][2][4][2], const pg8::Unit& u, int wr, int wc, int fr_, int fq_) const {
        const int ln_ = get_lane(); const int fr = ln_ & 15, fq = ln_ >> 4; (void)fr_; (void)fq_;
        const int row0 = u.pm * 256 + wr * 64 + fr, ch0 = 128 * u.pn + 32 * wc + 8 * fq; const float* bp = b1 + (size_t)u.aux * 2 * DFF + ch0;
        const f32x4 bg0 = *(const f32x4*)bp, bg1 = *(const f32x4*)(bp + 4), bl0 = *(const f32x4*)(bp + DFF), bl1 = *(const f32x4*)(bp + DFF + 4);
#pragma unroll
        for (int ai = 0; ai < 2; ++ai)
#pragma unroll
            for (int m = 0; m < 4; ++m) { const int row = row0 + ai * 128 + m * 16; float o[8];
#pragma unroll
                for (int n = 0; n < 2; ++n)
#pragma unroll
                    for (int ip = 0; ip < 2; ++ip) {
                        const f32x4 ag = acc[ai][0][m][n], al = acc[ai][1][m][n], bgv = n ? bg1 : bg0, blv = n ? bl1 : bl0;
                        const f32x2 a2 = {ag[2 * ip], ag[2 * ip + 1]}, l2 = {al[2 * ip], al[2 * ip + 1]}, bg2 = {bgv[2 * ip], bgv[2 * ip + 1]}, bl2 = {blv[2 * ip], blv[2 * ip + 1]};
                        f32x2 gl = a2 * FP8_DESCALE + bg2, li = l2 * FP8_DESCALE + bl2;
                        gl[0] = fminf(gl[0], 7.0f); gl[1] = fminf(gl[1], 7.0f); li[0] = fminf(fmaxf(li[0], -7.0f), 7.0f); li[1] = fminf(fmaxf(li[1], -7.0f), 7.0f);
                        const f32x2 xe = gl * (-1.702f * 1.4426950408889634f); f32x2 ee = {__builtin_amdgcn_exp2f(xe[0]), __builtin_amdgcn_exp2f(xe[1])}; ee = ee + 1.0f;
                        const f32x2 sg = {__builtin_amdgcn_rcpf(ee[0]), __builtin_amdgcn_rcpf(ee[1])};
                        const f32x2 ov = (gl * sg) * (li * FP8_AS + FP8_AS);
                        o[4 * n + 2 * ip] = ov[0]; o[4 * n + 2 * ip + 1] = ov[1]; }
                u32x2 w; w.x = cvt4_fp8(o[0], o[1], o[2], o[3]); w.y = cvt4_fp8(o[4], o[5], o[6], o[7]);
                *(u32x2*)(act + (unsigned)(row * DFF + ch0)) = w; } } };
constexpr float Y2_S = 32.0f;
struct EpiMoe2 { unsigned char* y2; const float* b2;
    __device__ __forceinline__ void operator()(const f32x4 (&acc)[2][2][4][2], const pg8::Unit& u, int wr, int wc, int fr_, int fq_) const {
        const int ln_ = get_lane(); const int fr = ln_ & 15, fq = ln_ >> 4; (void)fr_; (void)fq_;
        const int row0 = u.pm * 256 + wr * 64 + fr, col0 = 256 * u.pn + 32 * wc + 8 * fq; const float* bp = b2 + (size_t)u.aux * DM + col0;
        f32x4 bv[2][2];
#pragma unroll
        for (int bj = 0; bj < 2; ++bj) { bv[bj][0] = *(const f32x4*)(bp + 128 * bj) * Y2_S; bv[bj][1] = *(const f32x4*)(bp + 128 * bj + 4) * Y2_S; }
#pragma unroll
        for (int ai = 0; ai < 2; ++ai)
#pragma unroll
            for (int m = 0; m < 4; ++m) { const int row = row0 + ai * 128 + m * 16;
#pragma unroll
                for (int bj = 0; bj < 2; ++bj) { const f32x4 a = acc[ai][bj][m][0] * (FP8_DESCALE * Y2_S) + bv[bj][0], b = acc[ai][bj][m][1] * (FP8_DESCALE * Y2_S) + bv[bj][1];
                    u32x2 w; w.x = cvt4_fp8(a[0], a[1], a[2], a[3]); w.y = cvt4_fp8(b[0], b[1], b[2], b[3]);
                    *(u32x2*)(y2 + (unsigned)(row * DM + col0 + 128 * bj)) = w; } } } };

__device__ __forceinline__ void p9_final(const Frame& F, const Args& A) {
    LAS int* toff = (LAS int*)(F.lds + MISC_OFF + 64);
    (void)moe_tables(F, 8);
    const float* mod = (const float*)(F.ws + WS_MOD); const bf16_t* x1p = (const bf16_t*)(F.ws + WS_X1); const unsigned char* y2 = F.ws + WS_Y2;
    const int* toke = (const int*)(F.ws + WS_TOKE); const float* tokg = (const float*)(F.ws + WS_TOKG); const int* toks = (const int*)(F.ws + WS_TOKS);
    const int lane = F.lane;
    LAS float* PWL = (LAS float*)F.lds; LAS float* G2L = PWL + DM;
    static_assert((1 + NTOK / SEQ) * DM * 4 <= RING_BYTES && DM == 4 * 512, "P9 LDS");
    { *(LAS f32x4*)(PWL + 4 * F.tid) = *(const f32x4*)(ldp(F, I_POST_FFN) + 4 * F.tid);
#pragma unroll
      for (int bb = 0; bb < NTOK / SEQ; ++bb) *(LAS f32x4*)(G2L + bb * DM + 4 * F.tid) = *(const f32x4*)(mod + (size_t)bb * (6 * DM) + 5 * DM + 4 * F.tid); }
    __syncthreads();
    for (int row = F.bx * 8 + F.wave; row < NTOK; row += F.G * 8) {
        const float* mrow = mod + (size_t)(row / SEQ) * (6 * DM);
        f32x4 mo[8];
#pragma unroll
        for (int j = 0; j < 8; ++j) mo[j] = (f32x4){0.f, 0.f, 0.f, 0.f};
#pragma unroll
        for (int k = 0; k < 4; ++k) { const int e = toke[row * 4 + k]; const float gt = tokg[row * 4 + k]; const size_t r = (size_t)toff[e] * 256 + toks[row * 4 + k];
            const unsigned char* yp = y2 + r * DM + 4 * lane; const float gs = gt * (1.0f / Y2_S);
#pragma unroll
            for (int j = 0; j < 8; ++j) { const unsigned v = __builtin_nontemporal_load((const unsigned*)(yp + 256 * j));
                const auto lo = __builtin_amdgcn_cvt_pk_f32_fp8((int)v, false), hi = __builtin_amdgcn_cvt_pk_f32_fp8((int)v, true);
                mo[j][0] += gs * lo[0]; mo[j][1] += gs * lo[1]; mo[j][2] += gs * hi[0]; mo[j][3] += gs * hi[1]; } }
        float ss = 0.f;
#pragma unroll
        for (int j = 0; j < 8; ++j) ss += mo[j][0] * mo[j][0] + mo[j][1] * mo[j][1] + mo[j][2] * mo[j][2] + mo[j][3] * mo[j][3];
        const float rstd = rsqrtf(wave_sum(ss) * (1.0f / DM) + EPS);
#pragma unroll
        for (int j = 0; j < 8; ++j) { const int col = 4 * lane + 256 * j; const u32x2 xb = __builtin_nontemporal_load((const u32x2*)(x1p + (size_t)row * DM + col)); const f32x4 xv = (f32x4){bf_lo(xb.x), bf_hi(xb.x), bf_lo(xb.y), bf_hi(xb.y)}, pw = *(const LAS f32x4*)(PWL + col), g2 = *(const LAS f32x4*)(G2L + (row / SEQ) * DM + col);
            f32x4 o;
#pragma unroll
            for (int i = 0; i < 4; ++i) o[i] = xv[i] + g2[i] * (mo[j][i] * rstd * pw[i]);
            __builtin_nontemporal_store(o, (f32x4*)(ldp_out(F) + (size_t)row * DM + col)); }
    }
}

__global__ void __launch_bounds__(512, 2) fwd_kernel(Args args) {
    extern __shared__ __attribute__((aligned(16))) unsigned char lds_raw[];
    Frame F;
    F.lds = (LAS unsigned char*)lds_raw; F.wave = __builtin_amdgcn_readfirstlane((int)threadIdx.x >> 6); F.lane = get_lane(); F.tid = F.wave * 64 + F.lane; F.G = gridDim.x; F.bx = blockIdx.x;
    F.ws = args.ws; F.ctl = (unsigned*)(args.ws + WS_CTL);
    const Args& A = args;
    volatile LAS unsigned* MISC = (volatile LAS unsigned*)(F.lds + MISC_OFF);
    if (F.tid == 0) { LAS unsigned long long* pt = (LAS unsigned long long*)(F.lds + PTAB_OFF);
#pragma unroll
        for (int k = 0; k < 25; ++k) pt[k] = (unsigned long long)args.in[k];
        pt[25] = (unsigned long long)args.out; }
    if (F.tid < 4) MISC[F.tid] = 0u;
    __syncthreads();
#if N_LAUNCH_MODE == 1
    constexpr int lo = 0, hi = NPHASE; constexpr bool one = true;
#else
    const int lo = args.ph_lo, hi = args.ph_hi;
    const bool one = (hi - lo) > 1;
#endif
    XcdBarrier bar; bar.bar = F.ctl + CW_BAR; bar.x = 0; bar.st = MISC; bar.w0 = 0;
    if (one) bar = xcd_barrier_post(F.ctl + CW_BAR, MISC);
    bar.w0 = (F.wave == 0) ? 1 : 0;
#define IN(k) (lo <= (k) && (k) < hi)
#define REFRESH() do { F.lane = get_lane(); F.tid = F.wave * 64 + F.lane; } while (0)
#define SEAM(k) do { if (IN(k) && IN((k) + 1)) xcd_barrier(bar); } while (0)

    if (IN(0)) { REFRESH(); p0_prologue(F, A); } SEAM(0);
    if (IN(1)) { REFRESH(); p1_norm_mod(F, A); } SEAM(1);
    if (IN(2)) { REFRESH();
        const bool even = (F.G == 256);
        const int ntc = (F.bx < 64) ? 23 : 35, tb = (F.bx < 64) ? 23 * F.bx : 64 * 23 + (F.bx - 64) * 35;
        EpiIn E{F.ws};
        const int grp = (F.bx >> 3) & 3;
        EpiGlu8 E8{F.ws};
#pragma unroll 1
        for (int seg = 0; seg < 4; ++seg) {
            if (even && grp == seg) { REFRESH(); cvt_tiles_tp<true>(F, A, tb, 1, tb + ntc); REFRESH(); }
            if (seg >= 2) { SchedIn S{F.G, F.bx, seg == 2 ? 0 : 2, seg == 2 ? 2 : 1, true}; pg8::gemm_phase<EpiGlu8, SchedIn, false, true, false>(F.lds, F.ws, F.wave, DM, S, E8, nullptr); }
            else { SchedIn S{F.G, F.bx, 2 * seg, 2, false}; pg8::gemm_phase<EpiIn, SchedIn, false, false>(F.lds, F.ws, F.wave, DM * 2, S, E, nullptr); }
        }
        if (!even) cvt_tiles<true>(F, A, F.bx, F.G, NE * 256 + NE * 128);
    } SEAM(2);
    if (IN(3)) { REFRESH(); for (int u = F.bx; u < 256; u += F.G) p3_state_unit(F, A, u); for (int u = F.bx; u < 256; u += F.G) p3_conv_unit(F, A, u); } SEAM(3);
    if (IN(4)) { REFRESH(); p4_retention(F, A); } SEAM(4);
    if (IN(5)) { REFRESH(); EpiBf16 E{(bf16_t*)(F.ws + WS_MIX), DM, FP8_DESCALE};
        SchedDense S{(unsigned)WS_Y, (unsigned)WS_WOUT, 64, 8, F.G, F.bx, (unsigned)DM, 0, 1 << 20}; pg8::gemm_phase<EpiBf16, SchedDense, false, true, false>(F.lds, F.ws, F.wave, DM, S, E, nullptr);
    } SEAM(5);
    if (IN(6)) { REFRESH(); p6_mid(F, A); } SEAM(6);
    if (IN(7)) { REFRESH();
        (void)moe_tables(F, 16);
        const LAS int* utab = (const LAS int*)(F.lds + MISC_OFF + 512); const LAS int* toff = (const LAS int*)(F.lds + MISC_OFF + 64); const LAS int* cnt = (const LAS int*)(F.lds + MISC_OFF + 256);
        LAS unsigned* gtab = (LAS unsigned*)(F.lds + GTAB_OFF); const int* list = (const int*)(F.ws + WS_LIST);
        for (int idx = F.tid; idx < MAXU * 256; idx += 512) { const int i = idx >> 8, r = idx & 255, v = utab[i]; unsigned off = 0u;
            if (v >= 0) { const int pm = v & 4095, e = v >> 20, slot = (pm - toff[e]) * 256 + r; const int tok = (slot < cnt[e]) ? list[e * NTOK + slot] : 0; off = (unsigned)tok * (unsigned)DM; }
            gtab[idx] = off; }
        __syncthreads();
        EpiMoe1 E{F.ws + WS_ACT, ldp(F, I_B1)};
        const bool even = (F.G == 256); const int tb = 8192 + 16 * F.bx;
        const int grp = (F.bx & 7) % 3;
        if (even && grp == 0) { cvt_tiles_tp<true>(F, A, tb, 1, tb + 16); REFRESH(); }
        { SchedMoe S{(unsigned)WS_H2, (unsigned)WS_W1, utab, toff, 16, true, 0, 9}; pg8::gemm_phase<EpiMoe1, SchedMoe, true, true, false>(F.lds, F.ws, F.wave, DM, S, E, gtab); }
        if (even && grp == 1) { REFRESH(); cvt_tiles_tp<true>(F, A, tb, 1, tb + 16); REFRESH(); }
        { SchedMoe S{(unsigned)WS_H2, (unsigned)WS_W1, utab, toff, 16, true, 9, 1 << 20}; pg8::gemm_phase<EpiMoe1, SchedMoe, true, true, false>(F.lds, F.ws, F.wave, DM, S, E, gtab + 9 * 256); }
        if (even && grp == 2) { REFRESH(); cvt_tiles_tp<true>(F, A, tb, 1, tb + 16); }
    } SEAM(7);
    if (IN(8)) { REFRESH();
        (void)moe_tables(F, 8);
        const LAS int* utab = (const LAS int*)(F.lds + MISC_OFF + 512); const LAS int* toff = (const LAS int*)(F.lds + MISC_OFF + 64);
        SchedMoe S{(unsigned)WS_ACT, (unsigned)WS_W2, utab, toff, 8, false, 0, 1 << 20}; EpiMoe2 E{F.ws + WS_Y2, ldp(F, I_B2)};
        pg8::gemm_phase<EpiMoe2, SchedMoe, false, true, false>(F.lds, F.ws, F.wave, DFF, S, E, nullptr); } SEAM(8);
    if (IN(9)) { REFRESH(); p9_final(F, A); }
#undef IN
#undef SEAM
}

extern "C" void kernel_launch(void* const* d_in, const int* in_sizes, int n_in, void* d_out, int out_size, void* d_ws, size_t ws_size, hipStream_t stream) {
    static int grid = 0;
    if (grid == 0) {
        if (n_in != 25 || ws_size < WS_END) { fprintf(stderr, "kernel_launch: unexpected n_in %d or workspace %zu < %zu\n", n_in, ws_size, (size_t)WS_END); grid = -1; return; }
        int dev = 0, cus = 0, per_cu = 0;
        if (hipGetDevice(&dev) != hipSuccess || hipDeviceGetAttribute(&cus, hipDeviceAttributeMultiprocessorCount, dev) != hipSuccess) { grid = -1; return; }
        if (hipFuncSetAttribute((const void*)fwd_kernel, hipFuncAttributeMaxDynamicSharedMemorySize, LDS_BYTES) != hipSuccess) { fprintf(stderr, "kernel_launch: hipFuncSetAttribute failed\n"); grid = -1; return; }
        if (hipOccupancyMaxActiveBlocksPerMultiprocessor(&per_cu, (const void*)fwd_kernel, 512, LDS_BYTES) != hipSuccess || per_cu < 1) { fprintf(stderr, "kernel_launch: occupancy query says %d\n", per_cu); }
        (void)hipGetLastError();
        grid = cus;
    }
    if (grid < 0) return;
    (void)hipMemsetAsync((char*)d_ws + WS_CTL, 0, CTL_ZERO_BYTES, stream);
    Args a{};
    for (int i = 0; i < 25; ++i) a.in[i] = (const float*)d_in[i];
    a.out = (float*)d_out; a.ws = (unsigned char*)d_ws;
#if N_LAUNCH_MODE == 1
    a.ph_lo = 0; a.ph_hi = NPHASE;
    hipLaunchKernelGGL(fwd_kernel, dim3(grid), dim3(512), LDS_BYTES, stream, a);
#else
    for (int p = 0; p < NPHASE; ++p) { a.ph_lo = p; a.ph_hi = p + 1; hipLaunchKernelGGL(fwd_kernel, dim3(grid), dim3(512), LDS_BYTES, stream, a); }
#endif
}
```
